# Optimizing an MI355X kernel written in HIP

```python
import jax
import jax.numpy as jnp
from jax import lax
import numpy as np

D_MODEL = 2048
BATCH = 8
SEQ = 2048
DEPTH = 2

GRID_W = 64
CTX_LEN = 256
HEAD_DIM = 128
N_HEADS = 8
N_KV_HEADS = 2
KV_GROUP = N_HEADS // N_KV_HEADS
Q_W = N_HEADS * HEAD_DIM
KV_W = N_KV_HEADS * HEAD_DIM
Q_BLOCK = 128
ROPE_THETA = 10000.0
ROPE_AXIS_DIM = HEAD_DIM // 2
POOL_WINDOWS = (2, 4, 8, 16)
POOL_GROUPS = len(POOL_WINDOWS)
POOL_W = D_MODEL // 4
POOL_GC = POOL_W // POOL_GROUPS
SGU_W = D_MODEL // 4
SGU_GROUPS = 4
SGU_GC = SGU_W // SGU_GROUPS
SGU_CHUNK = 128
CONV_W = D_MODEL // 4
CONV_K = 3
N_BRANCH = 4
D_FF = -(-8 * D_MODEL // (3 * 256)) * 256
ALPHA = (2 * DEPTH) ** 0.25
BETA = (8 * DEPTH) ** -0.25
LN_EPS = 1e-5
RMS_EPS = 1e-6

OFF_K = Q_W
OFF_V = OFF_K + KV_W
OFF_POOL = OFF_V + KV_W
OFF_U = OFF_POOL + POOL_W
OFF_VG = OFF_U + SGU_W
OFF_CB = OFF_VG + SGU_W
OFF_CC = OFF_CB + CONV_W
OFF_CX = OFF_CC + CONV_W
IN_W = OFF_CX + CONV_W

kernel_name = 'hybrid_diffusion_parallel_mixer'


def layer_norm(x, g, b):
    xf = x.astype(jnp.float32)
    mu = jnp.mean(xf, axis=-1, keepdims=True)
    var = jnp.mean(jnp.square(xf - mu), axis=-1, keepdims=True)
    return ((xf - mu) * lax.rsqrt(var + LN_EPS) * g + b).astype(x.dtype)


def rms_norm(x, g):
    xf = x.astype(jnp.float32)
    ms = jnp.mean(jnp.square(xf), axis=-1, keepdims=True)
    return (xf * lax.rsqrt(ms + RMS_EPS) * g).astype(x.dtype)


def axial_rope_tables(n, dtype):
    rows = n // GRID_W
    row = jnp.repeat(jnp.arange(rows), GRID_W).astype(jnp.float32)
    col = jnp.tile(jnp.arange(GRID_W), rows).astype(jnp.float32)
    inv = ROPE_THETA ** (-jnp.arange(0, ROPE_AXIS_DIM, 2, dtype=jnp.float32) / ROPE_AXIS_DIM)
    ang_r = row[:, None] * inv
    ang_c = col[:, None] * inv
    f = lambda a: a[None, :, None, :].astype(dtype)
    return (f(jnp.cos(ang_r)), f(jnp.sin(ang_r)), f(jnp.cos(ang_c)), f(jnp.sin(ang_c)))


def rotate(x, cos, sin):
    h = x.shape[-1] // 2
    x1, x2 = x[..., :h], x[..., h:]
    return jnp.concatenate([x1 * cos - x2 * sin, x2 * cos + x1 * sin], axis=-1)


def apply_axial_rope(x, tables):
    cr, sr, cc, sc = tables
    return jnp.concatenate([rotate(x[..., :ROPE_AXIS_DIM], cr, sr),
                            rotate(x[..., ROPE_AXIS_DIM:], cc, sc)], axis=-1)


def block_attention(q, k, v):
    b, n, h, d = q.shape
    nb = n // Q_BLOCK
    qb = q.reshape(b, nb, Q_BLOCK, N_KV_HEADS, KV_GROUP, d).transpose(1, 0, 2, 3, 4, 5)
    scale = d ** -0.5

    def one_block(qi):
        s = jnp.einsum('bqkgd,bskd->bkgqs', qi, k, preferred_element_type=jnp.float32) * scale
        p = jax.nn.softmax(s, axis=-1).astype(v.dtype)
        return jnp.einsum('bkgqs,bskd->bqkgd', p, v)

    o = lax.map(one_block, qb)
    return o.transpose(1, 0, 2, 3, 4, 5).reshape(b, n, h * d)


def kv_heads(pkv, k_g):
    b, n, _ = pkv.shape
    k = rms_norm(pkv[..., :KV_W].reshape(b, n, N_KV_HEADS, HEAD_DIM), k_g)
    v = pkv[..., KV_W:].reshape(b, n, N_KV_HEADS, HEAD_DIM)
    return k, v


def multiscale_pool(z):
    b, n, ch = z.shape
    cs = jnp.cumsum(z.astype(jnp.float32), axis=1)
    cs = jnp.concatenate([jnp.zeros((b, 1, ch), jnp.float32), cs], axis=1)
    t = jnp.arange(n)
    means = []
    for g, w in enumerate(POOL_WINDOWS):
        left = w // 2
        right = w - 1 - left
        hi = jnp.clip(t + right + 1, 0, n)
        lo = jnp.clip(t - left, 0, n)
        seg = cs[:, :, g * POOL_GC:(g + 1) * POOL_GC]
        total = jnp.take(seg, hi, axis=1) - jnp.take(seg, lo, axis=1)
        means.append(total / (hi - lo).astype(jnp.float32)[None, :, None])
    return jnp.concatenate(means, axis=-1).astype(z.dtype) - z


def spatial_gating(u, v, ln_g, ln_b, w_s, b_s):
    b, n, _ = v.shape
    v = layer_norm(v, ln_g, ln_b)
    vc = v.reshape(b, n // SGU_CHUNK, SGU_CHUNK, SGU_GROUPS, SGU_GC)
    s = jnp.einsum('gpq,bnqgc->bnpgc', w_s, vc) + b_s.T[None, None, :, :, None]
    return u * s.reshape(b, n, SGU_W)


def short_conv(z, w):
    zp = jnp.pad(z, ((0, 0), (1, 1), (0, 0)))
    return zp[:, :-2] * w[0] + zp[:, 1:-1] * w[1] + zp[:, 2:] * w[2]


def local_branches(pr, pool_w, pool_scale, sgu_ln_g, sgu_ln_b, sgu_w, sgu_b, conv_w):
    b, n, _ = pr.shape
    d = multiscale_pool(pr[..., OFF_POOL:OFF_U])
    y_pool = jnp.einsum('bngc,gce->bnge', d.reshape(b, n, POOL_GROUPS, POOL_GC), pool_w).reshape(b, n, POOL_W) * pool_scale
    y_sgu = spatial_gating(jax.nn.gelu(pr[..., OFF_U:OFF_VG]), jax.nn.gelu(pr[..., OFF_VG:OFF_CB]),
                           sgu_ln_g, sgu_ln_b, sgu_w, sgu_b)
    y_conv = pr[..., OFF_CB:OFF_CC] * short_conv(pr[..., OFF_CC:OFF_CX] * pr[..., OFF_CX:IN_W], conv_w)
    return y_pool, y_sgu, y_conv


def merge_branches(h, branches, w_brs, w_gate, b_gate, w_o):
    terms = []
    for k in range(N_BRANCH):
        g = jax.nn.sigmoid(h @ w_gate[:, k * D_MODEL:(k + 1) * D_MODEL] + b_gate[k * D_MODEL:(k + 1) * D_MODEL])
        terms.append(g * (branches[k] @ w_brs[k]))
    merged = terms[0] + terms[1] + terms[2] + terms[3]
    return merged @ w_o


def hybrid_mixer(h_c, h_l, rope, ctx_out, w_in, q_g, k_g, pool_w, pool_scale, sgu_ln_g, sgu_ln_b,
                 sgu_w, sgu_b, conv_w, w_br_attn, w_br_pool, w_br_sgu, w_br_conv, w_gate, b_gate, w_o):
    b, n, _ = h_l.shape
    nc = h_c.shape[1]
    w_brs = (w_br_attn, w_br_pool, w_br_sgu, w_br_conv)
    p_l = h_l @ w_in
    q_l = apply_axial_rope(rms_norm(p_l[..., :Q_W].reshape(b, n, N_HEADS, HEAD_DIM), q_g), rope)
    k_l, v_l = kv_heads(p_l[..., OFF_K:OFF_POOL], k_g)
    k_l = apply_axial_rope(k_l, rope)
    if ctx_out:
        p_c = h_c @ w_in
        pkv_c = p_c[..., OFF_K:OFF_POOL]
    else:
        pkv_c = h_c @ w_in[:, OFF_K:OFF_POOL]
    k_c, v_c = kv_heads(pkv_c, k_g)
    a_l = block_attention(q_l, jnp.concatenate([k_c, k_l], axis=1), jnp.concatenate([v_c, v_l], axis=1))
    out_l = merge_branches(h_l, (a_l,) + local_branches(p_l, pool_w, pool_scale, sgu_ln_g, sgu_ln_b, sgu_w, sgu_b, conv_w),
                           w_brs, w_gate, b_gate, w_o)
    if not ctx_out:
        return None, out_l
    q_c = rms_norm(p_c[..., :Q_W].reshape(b, nc, N_HEADS, HEAD_DIM), q_g)
    a_c = block_attention(q_c, k_c, v_c)
    out_c = merge_branches(h_c, (a_c,) + local_branches(p_c, pool_w, pool_scale, sgu_ln_g, sgu_ln_b, sgu_w, sgu_b, conv_w),
                           w_brs, w_gate, b_gate, w_o)
    return out_c, out_l


def swiglu(h, w_g, w_u, w_d):
    return (jax.nn.silu(h @ w_g) * (h @ w_u)) @ w_d


def setup_inputs(seed: int = 0) -> dict:
    key = jax.random.key(seed)
    ks = jax.random.split(key, 32)

    def nrm(k, shape, std):
        return jax.random.normal(k, shape, jnp.float32) * std

    def gain(k, shape):
        return 1.0 + nrm(k, shape, 0.02)

    L = DEPTH
    d = D_MODEL
    return {
        'x': nrm(ks[0], (BATCH, SEQ, d), 1.0),
        'c': nrm(ks[1], (BATCH, d), 1.0),
        'ctx': nrm(ks[2], (BATCH, CTX_LEN, d), 1.0),
        'c_ctx': nrm(ks[3], (d,), 1.0),
        'w_ada': nrm(ks[4], (L, d, 6 * d), 0.5 * d ** -0.5),
        'b_ada': nrm(ks[5], (L, 6 * d), 0.01),
        'w_in': nrm(ks[6], (L, d, IN_W), d ** -0.5),
        'q_norm_g': gain(ks[7], (L, HEAD_DIM)),
        'k_norm_g': gain(ks[8], (L, HEAD_DIM)),
        'pool_w': nrm(ks[9], (L, POOL_GROUPS, POOL_GC, POOL_GC), POOL_GC ** -0.5),
        'pool_scale': 1.0 + nrm(ks[10], (L, POOL_W), 0.1),
        'sgu_ln_g': gain(ks[11], (L, SGU_W)),
        'sgu_ln_b': nrm(ks[12], (L, SGU_W), 0.02),
        'sgu_w': nrm(ks[13], (L, SGU_GROUPS, SGU_CHUNK, SGU_CHUNK), SGU_CHUNK ** -0.5),
        'sgu_b': 1.0 + nrm(ks[14], (L, SGU_GROUPS, SGU_CHUNK), 0.02),
        'conv_w': nrm(ks[15], (L, CONV_K, CONV_W), CONV_K ** -0.5),
        'w_br_attn': nrm(ks[16], (L, Q_W, d), Q_W ** -0.5),
        'w_br_pool': nrm(ks[17], (L, POOL_W, d), POOL_W ** -0.5),
        'w_br_sgu': nrm(ks[18], (L, SGU_W, d), SGU_W ** -0.5),
        'w_br_conv': nrm(ks[19], (L, CONV_W, d), CONV_W ** -0.5),
        'w_gate': nrm(ks[20], (L, d, N_BRANCH * d), d ** -0.5),
        'b_gate': nrm(ks[21], (L, N_BRANCH * d), 0.01),
        'w_o': nrm(ks[22], (L, d, d), BETA * d ** -0.5),
        'ln1_g': gain(ks[23], (L, d)),
        'ln1_b': nrm(ks[24], (L, d), 0.02),
        'w_ff_gate': nrm(ks[25], (L, d, D_FF), d ** -0.5),
        'w_ff_up': nrm(ks[26], (L, d, D_FF), d ** -0.5),
        'w_ff_down': nrm(ks[27], (L, D_FF, d), BETA * D_FF ** -0.5),
        'ln2_g': gain(ks[28], (L, d)),
        'ln2_b': nrm(ks[29], (L, d), 0.02),
    }


def reference(x, c, ctx, c_ctx, w_ada, b_ada, w_in, q_norm_g, k_norm_g, pool_w, pool_scale,
              sgu_ln_g, sgu_ln_b, sgu_w, sgu_b, conv_w, w_br_attn, w_br_pool, w_br_sgu, w_br_conv,
              w_gate, b_gate, w_o, ln1_g, ln1_b, w_ff_gate, w_ff_up, w_ff_down, ln2_g, ln2_b):
    rope = axial_rope_tables(x.shape[1], x.dtype)
    x_l, x_c = x, ctx
    for i in range(DEPTH):
        last = i == DEPTH - 1
        mod_l = jax.nn.silu(c) @ w_ada[i] + b_ada[i]
        mod_c = jax.nn.silu(c_ctx) @ w_ada[i] + b_ada[i]
        sh1_l, sc1_l, g1_l, sh2_l, sc2_l, g2_l = jnp.split(mod_l[:, None, :], 6, axis=-1)
        sh1_c, sc1_c, g1_c, sh2_c, sc2_c, g2_c = jnp.split(mod_c, 6, axis=-1)
        h_l = x_l * (1.0 + sc1_l) + sh1_l
        h_c = x_c * (1.0 + sc1_c) + sh1_c
        m_c, m_l = hybrid_mixer(h_c, h_l, rope, not last, w_in[i], q_norm_g[i], k_norm_g[i], pool_w[i],
                                pool_scale[i], sgu_ln_g[i], sgu_ln_b[i], sgu_w[i], sgu_b[i], conv_w[i],
                                w_br_attn[i], w_br_pool[i], w_br_sgu[i], w_br_conv[i], w_gate[i], b_gate[i], w_o[i])
        x_l = layer_norm(ALPHA * x_l + g1_l * m_l, ln1_g[i], ln1_b[i])
        h_l = x_l * (1.0 + sc2_l) + sh2_l
        x_l = layer_norm(ALPHA * x_l + g2_l * swiglu(h_l, w_ff_gate[i], w_ff_up[i], w_ff_down[i]), ln2_g[i], ln2_b[i])
        if not last:
            x_c = layer_norm(ALPHA * x_c + g1_c * m_c, ln1_g[i], ln1_b[i])
            h_c = x_c * (1.0 + sc2_c) + sh2_c
            x_c = layer_norm(ALPHA * x_c + g2_c * swiglu(h_c, w_ff_gate[i], w_ff_up[i], w_ff_down[i]), ln2_g[i], ln2_b[i])
    return x_l
```

```cpp
#include <hip/hip_runtime.h>
#include <hip/hip_bf16.h>
#include <hip/hip_cooperative_groups.h>
#include <cstdio>
#include <cstdint>
namespace cg = cooperative_groups;

#ifndef MK_ONE_LAUNCH
#define MK_ONE_LAUNCH 1
#endif

#define LAS __attribute__((address_space(3)))
typedef unsigned short bf16_t;
typedef short bf16x8 __attribute__((ext_vector_type(8)));
typedef short s16x4 __attribute__((ext_vector_type(4)));
typedef float f32x4 __attribute__((ext_vector_type(4)));
typedef float f32x16 __attribute__((ext_vector_type(16)));
typedef unsigned u32x4 __attribute__((ext_vector_type(4)));
typedef unsigned u32x2 __attribute__((ext_vector_type(2)));
typedef int i32x4 __attribute__((ext_vector_type(4)));
typedef int i32x8 __attribute__((ext_vector_type(8)));

constexpr int DM = 2048, NBATCH = 8, SEQ = 2048, CTXL = 256;
constexpr int ML = NBATCH * SEQ, MC = NBATCH * CTXL, MT = ML + MC;
constexpr int INW = 4608, GW = 8192, NA = INW + GW, BRK = 2560, DFF = 5632, NDU = 2 * DFF;
constexpr int KVLEN = CTXL + SEQ;
constexpr int MODW = 6 * DM;
constexpr float ALPHA = 1.4142135623730951f;
constexpr float LN_EPS = 1e-5f, RMS_EPS = 1e-6f;

constexpr size_t MiB = 1u << 20;
constexpr size_t WS_ROPE = 0;
constexpr size_t WS_BAR = 65536;
constexpr size_t WS_MOD = 1 * MiB;
constexpr size_t WS_WA = 2 * MiB;
constexpr size_t WS_WB = WS_WA + 50 * MiB;
constexpr size_t WS_WC = WS_WB + 10 * MiB;
constexpr size_t WS_WD = WS_WC + 8 * MiB;
constexpr size_t WS_WE = WS_WD + 44 * MiB;
constexpr size_t WS_XC = WS_WE + 22 * MiB;
constexpr size_t WS_H = WS_XC + 16 * MiB;
constexpr size_t WS_P = WS_H + 72 * MiB;
constexpr size_t WS_G = WS_P + 162 * MiB;
constexpr size_t WS_BR = WS_G + 288 * MiB;
constexpr size_t WS_QB = WS_BR + 90 * MiB;
constexpr size_t WS_KB = WS_QB + 36 * MiB;
constexpr size_t WS_VB = WS_KB + 9 * MiB;
constexpr size_t WS_END = WS_VB + 9 * MiB;
constexpr size_t WS_H8 = WS_BR;
constexpr size_t WS_WG8 = WS_WA + 18 * MiB;
constexpr float WG8_SCALE = 64.f;

constexpr int LDS_BYTES = 147456;

typedef float f32x2_t __attribute__((ext_vector_type(2)));
typedef __bf16 bf16x2_t __attribute__((ext_vector_type(2)));
__device__ __forceinline__ unsigned cvt_pk_bf16(float lo, float hi) { f32x2_t v = {lo, hi}; bf16x2_t r = __builtin_convertvector(v, bf16x2_t); return __builtin_bit_cast(unsigned, r); }
__device__ __forceinline__ float bflo(unsigned w) { return __uint_as_float(w << 16); }
__device__ __forceinline__ float bfhi(unsigned w) { return __uint_as_float(w & 0xffff0000u); }
__device__ __forceinline__ float bf2f(bf16_t h) { return __uint_as_float((unsigned)h << 16); }
__device__ __forceinline__ bf16_t f2bf(float f) { return (bf16_t)(cvt_pk_bf16(f, 0.f) & 0xffffu); }
__device__ __forceinline__ float sigmoidf_(float x) { return __builtin_amdgcn_rcpf(1.f + __builtin_amdgcn_exp2f(-1.4426950408889634f * x)); }
__device__ __forceinline__ float gelu_tanh(float x) { const float z = 1.5957691216057308f * (x + 0.044715f * x * x * x); return x * sigmoidf_(z); }
__device__ __forceinline__ float wave_sum(float v) {
#pragma unroll
    for (int o = 1; o < 64; o <<= 1) v += __shfl_xor(v, o);
    return v;
}
#define LDS_WAIT() asm volatile("s_waitcnt lgkmcnt(0)" ::: "memory")
__device__ __forceinline__ int opaque_tid() { int t = threadIdx.x; asm volatile("" : "+v"(t)); return t; }

namespace pg8 {
constexpr int BM = 256, BK = 64, HALF = 128, HTB = HALF * BK * 2, STAGE_BYTES = 8 * HTB;
__host__ __device__ __forceinline__ int lds_byte(int r, int c) { const int st = (r >> 4) * 2 + (c >> 5), rr = r & 15, cc = c & 31, ob = rr * 64 + cc * 2; return st * 1024 + (ob ^ (((ob >> 9) & 1) << 5)); }
__host__ __device__ __forceinline__ void stage_rc(int b, int& R, int& C) { const int st = b / 1024, sb = b % 1024, swz = sb ^ (((sb >> 9) & 1) << 5); R = (st >> 1) * 16 + swz / 64; C = (st & 1) * 32 + (swz % 64) / 2; }
__host__ __device__ __forceinline__ int perm32(int rho) { const int n = rho >> 4, i = rho & 15; return 8 * (i >> 2) + 4 * n + (i & 3); }

struct Unit { int pm, pn, seg, nt, f8; const char* a; const char* b; };

__device__ __forceinline__ void tile_of(int L, int nM, int nN, int& pm, int& pn) {
    const int nwg = nM * nN; int wgid = L;
    { const int q = nwg / 8, r = nwg % 8, xcd = wgid % 8, off = wgid / 8; wgid = (xcd < r ? xcd * (q + 1) : r * (q + 1) + (xcd - r) * q) + off; }
    const int nig = 8 * nN, gid = wgid / nig, fm = gid * 8, gsz = (nM - fm) < 8 ? (nM - fm) : 8;
    pm = fm + ((wgid % nig) % gsz); pn = (wgid % nig) / gsz;
}

template <class Epi, class Sched, bool F8 = false>
__device__ __forceinline__ void gemm_phase(LAS unsigned char* lds, const int ld, const Sched& S, const Epi& E) {
    const int tid = opaque_tid(), wid = __builtin_amdgcn_readfirstlane(tid >> 6), lane = tid & 63, wr = wid >> 2, wc = wid & 3, fr = lane & 15, fq = lane >> 4;
    unsigned voffA[2], voffB[2];
#pragma unroll
    for (int i = 0; i < 2; ++i) { int R, C; stage_rc(tid * 16 + i * 8192, R, C); const int Rb = Epi::PERM ? ((R & ~31) + perm32(R & 31)) : R;
        voffA[i] = (unsigned)(R * ld + C) * 2u; voffB[i] = (unsigned)(Rb * ld + C) * 2u; }
    const size_t kstep = (size_t)(BK * 2);
    const size_t hstep = (size_t)HALF * ld * 2;
    const unsigned ldsw = (unsigned)wid * 1024u;
    const int aoff = lds_byte(wr * 64 + fr, fq * 8), boff = lds_byte(wc * 32 + fr, fq * 8);
#define PG8_SA(b, h) (((b) * 2 + (h)) * HTB)
#define PG8_SB(b, h) ((4 + (b) * 2 + (h)) * HTB)
#define PG8_STAGE(bufoff, gbase, voff) do { _Pragma("unroll") for (int _i = 0; _i < 2; ++_i) \
        __builtin_amdgcn_global_load_lds((const unsigned*)((const char*)(gbase) + (voff)[_i]), (LAS unsigned*)(lds + (bufoff) + ldsw + _i * 8192), 16, 0, 0); } while (0)
#define PG8_LD8(p) __builtin_shufflevector(*(const LAS i32x4*)(p), *(const LAS i32x4*)((p) + 1024), 0, 1, 2, 3, 4, 5, 6, 7)
#define PG8_LDA(dst, b, h) do { _Pragma("unroll") for (int m = 0; m < 4; ++m) dst[m] = PG8_LD8(lds + PG8_SA(b, h) + aoff + m * 2048); } while (0)
#define PG8_LDB(dst, b, h) do { _Pragma("unroll") for (int n = 0; n < 2; ++n) dst[n] = PG8_LD8(lds + PG8_SB(b, h) + boff + n * 2048); } while (0)
#define PG8_LO(x) __builtin_bit_cast(bf16x8, __builtin_shufflevector(x, x, 0, 1, 2, 3))
#define PG8_HI(x) __builtin_bit_cast(bf16x8, __builtin_shufflevector(x, x, 4, 5, 6, 7))
#define PG8_MMA16(ai, bj, At, Bt) do { __builtin_amdgcn_s_setprio(1); _Pragma("unroll") for (int m = 0; m < 4; ++m) _Pragma("unroll") for (int n = 0; n < 2; ++n) { \
        acc[ai][bj][m][n] = __builtin_amdgcn_mfma_f32_16x16x32_bf16(PG8_LO(Bt[n]), PG8_LO(At[m]), acc[ai][bj][m][n], 0, 0, 0); \
        acc[ai][bj][m][n] = __builtin_amdgcn_mfma_f32_16x16x32_bf16(PG8_HI(Bt[n]), PG8_HI(At[m]), acc[ai][bj][m][n], 0, 0, 0); } __builtin_amdgcn_s_setprio(0); } while (0)
#define PG8_MMA8(ai, bj, At, Bt) do { __builtin_amdgcn_s_setprio(1); _Pragma("unroll") for (int m = 0; m < 4; ++m) _Pragma("unroll") for (int n = 0; n < 2; ++n) \
        asm volatile("v_mfma_scale_f32_16x16x128_f8f6f4 %0, %1, %2, %0, %3, %3 op_sel_hi:[0,0,0]" : "+v"(acc[ai][bj][m][n]) : "v"(Bt[n]), "v"(At[m]), "v"(sc1)); \
        __builtin_amdgcn_s_setprio(0); } while (0)
#define PG8_WAIT_V(n) asm volatile("s_waitcnt vmcnt(" #n ")" ::: "memory")
#define PG8_WAIT_L(n) asm volatile("s_waitcnt lgkmcnt(" #n ")" ::: "memory")
#define PG8_BAR __builtin_amdgcn_s_barrier()
#define PG8_SCHED __builtin_amdgcn_sched_barrier(0)
#define PG8_KLOOP(MMA) for (int t = 0; t < nt; t += 2) { \
            const bool last = (t == nt - 2); \
            const char* a1 = cA + (size_t)(t + 1) * kstep; \
            const char* a2 = last ? nA : cA + (size_t)(t + 2) * kstep; const char* b2 = last ? nB : cB + (size_t)(t + 2) * kstep; \
            const char* a3 = a2 + kstep; const char* b3 = b2 + kstep; \
            PG8_LDB(B0, 0, 0); PG8_LDB(B1, 0, 1); PG8_SCHED; PG8_LDA(At, 0, 0); PG8_STAGE(PG8_SA(1, 1), a1 + hstep, voffA); \
            PG8_WAIT_V(8); PG8_WAIT_L(0); PG8_BAR; MMA(0, 0, At, B0); MMA(0, 1, At, B1); PG8_BAR; PG8_SCHED; \
            PG8_LDA(At, 0, 1); PG8_STAGE(PG8_SB(0, 0), b2, voffB); PG8_STAGE(PG8_SB(0, 1), b2 + hstep, voffB); PG8_STAGE(PG8_SA(0, 0), a2, voffA); \
            PG8_WAIT_V(8); PG8_WAIT_L(0); PG8_BAR; MMA(1, 0, At, B0); MMA(1, 1, At, B1); PG8_BAR; PG8_SCHED; \
            PG8_LDB(B0, 1, 0); PG8_LDB(B1, 1, 1); PG8_SCHED; PG8_LDA(At, 1, 0); PG8_STAGE(PG8_SA(0, 1), a2 + hstep, voffA); \
            PG8_WAIT_V(8); PG8_WAIT_L(0); PG8_BAR; MMA(0, 0, At, B0); MMA(0, 1, At, B1); PG8_BAR; PG8_SCHED; \
            PG8_LDA(At, 1, 1); PG8_STAGE(PG8_SB(1, 0), b3, voffB); PG8_STAGE(PG8_SB(1, 1), b3 + hstep, voffB); PG8_STAGE(PG8_SA(1, 0), a3, voffA); \
            PG8_WAIT_V(8); PG8_WAIT_L(0); PG8_BAR; MMA(1, 0, At, B0); MMA(1, 1, At, B1); PG8_BAR; PG8_SCHED; }
    Unit cur, nxt; int ui = 0;
    if (!S.next(0, cur)) return;
    f32x4 acc[2][2][4][2];
#pragma unroll
    for (int a = 0; a < 2; ++a)
#pragma unroll
        for (int b = 0; b < 2; ++b)
#pragma unroll
            for (int m = 0; m < 4; ++m)
#pragma unroll
                for (int n = 0; n < 2; ++n) acc[a][b][m][n] = (f32x4){0.f, 0.f, 0.f, 0.f};
    i32x8 At[4], B0[2], B1[2];
    const int sc1 = 0x7f7f7f7f;
    const char* cA = cur.a; const char* cB = cur.b;
    {
        PG8_STAGE(PG8_SB(0, 0), cB, voffB); PG8_STAGE(PG8_SB(0, 1), cB + hstep, voffB); PG8_STAGE(PG8_SA(0, 0), cA, voffA); PG8_STAGE(PG8_SA(0, 1), cA + hstep, voffA);
        if (wr == 1) PG8_BAR;
        PG8_WAIT_V(2); PG8_BAR;
        PG8_STAGE(PG8_SB(1, 0), cB + kstep, voffB); PG8_STAGE(PG8_SA(1, 0), cA + kstep, voffA); PG8_STAGE(PG8_SB(1, 1), cB + hstep + kstep, voffB);
        PG8_WAIT_V(6); PG8_BAR;
    }
    for (;;) {
        const bool has_next = S.next(ui + 1, nxt);
        const char* nA = has_next ? nxt.a : cA; const char* nB = has_next ? nxt.b : cB;
        const int nt = cur.nt;
        if constexpr (F8) { PG8_KLOOP(PG8_MMA8) asm volatile("s_nop 15\n\ts_nop 15" ::: "memory"); } else { PG8_KLOOP(PG8_MMA16) }
        if (wr == 0) PG8_BAR;
        E(acc, cur, wr, wc, fr, fq);
        if (!has_next) break;
        if (!(Epi::CARRY && cur.seg < 3)) {
#pragma unroll
            for (int a = 0; a < 2; ++a)
#pragma unroll
                for (int b = 0; b < 2; ++b)
#pragma unroll
                    for (int m = 0; m < 4; ++m)
#pragma unroll
                        for (int n = 0; n < 2; ++n) acc[a][b][m][n] = (f32x4){0.f, 0.f, 0.f, 0.f}; }
        cur = nxt; cA = nA; cB = nB; ++ui;
        if (wr == 1) PG8_BAR;
    }
    PG8_WAIT_V(0);
    PG8_BAR;
#undef PG8_SA
#undef PG8_SB
#undef PG8_STAGE
#undef PG8_LDA
#undef PG8_LDB
#undef PG8_MMA16
#undef PG8_MMA8
#undef PG8_LD8
#undef PG8_LO
#undef PG8_HI
#undef PG8_KLOOP
#undef PG8_WAIT_V
#undef PG8_WAIT_L
#undef PG8_BAR
#undef PG8_SCHED
}

struct SchedG {
    const char* A; const char* B; int rowB, nM, nN, nt, G, c, nExtra, exPm0, exPn0, exNm, pn0;
    __device__ __forceinline__ bool next(int i, Unit& u) const {
        const int L = i * G + c, nwg = nM * nN;
        if (L < nwg) tile_of(L, nM, nN, u.pm, u.pn);
        else if (L < nwg + nExtra) { const int idx = L - nwg; u.pm = exPm0 + idx % exNm; u.pn = exPn0 + idx / exNm; }
        else return false;
        u.seg = 0; u.f8 = 0; u.nt = nt; u.a = A + (size_t)u.pm * 256 * rowB; u.b = B + (size_t)u.pn * 256 * rowB; u.pn += pn0; return true;
    }
};
struct SchedSeg {
    const char* A; const char* B; int ld, nM, nN, G, c;
    __device__ __forceinline__ bool next(int i, Unit& u) const {
        const int L = (i >> 2) * G + c; if (L >= nM * nN) return false;
        tile_of(L, nM, nN, u.pm, u.pn);
        const int s = i & 3; u.seg = s; u.f8 = 0; u.nt = s == 0 ? 16 : 8; const int koff = s == 0 ? 0 : 512 + 512 * s;
        u.a = A + ((size_t)u.pm * 256 * ld + koff) * 2; u.b = B + ((size_t)u.pn * 256 * ld + koff) * 2; return true;
    }
};

struct EpiP {
    static constexpr bool PERM = true, CARRY = false;
    bf16_t* P;
    __device__ __forceinline__ void operator()(const f32x4 (&acc)[2][2][4][2], const Unit& u, int wr, int wc, int fr, int fq) const {
        const int row0 = u.pm * 256 + wr * 64 + fr; const int colt = u.pn * 256 + wc * 32 + 8 * fq;
#pragma unroll
        for (int ai = 0; ai < 2; ++ai)
#pragma unroll
            for (int m = 0; m < 4; ++m) { bf16_t* rowp = P + (size_t)(row0 + ai * 128 + m * 16) * INW + colt;
#pragma unroll
                for (int bj = 0; bj < 2; ++bj) { const f32x4 v0 = acc[ai][bj][m][0], v1 = acc[ai][bj][m][1];
                    u32x4 w; w.x = cvt_pk_bf16(v0[0], v0[1]); w.y = cvt_pk_bf16(v0[2], v0[3]); w.z = cvt_pk_bf16(v1[0], v1[1]); w.w = cvt_pk_bf16(v1[2], v1[3]);
                    *(u32x4*)(rowp + bj * 128) = w; } }
    }
};
struct EpiG {
    static constexpr bool PERM = true, CARRY = false;
    bf16_t* Gt; const float* bg;
    __device__ __forceinline__ void operator()(const f32x4 (&acc)[2][2][4][2], const Unit& u, int wr, int wc, int fr, int fq) const {
        const int t512 = (wr * 4 + wc) * 64 + fq * 16 + fr;
        const int gc = (u.pn - 18) * 256 + wc * 32 + 8 * fq;
        f32x4 bv[2][2];
#pragma unroll
        for (int bj = 0; bj < 2; ++bj)
#pragma unroll
            for (int n = 0; n < 2; ++n) bv[bj][n] = *(const f32x4*)(bg + gc + bj * 128 + 4 * n);
        u32x4* gdst = (u32x4*)Gt + (size_t)(u.pm * 32 + (u.pn - 18)) * 8192 + t512;
        constexpr float SC = 1.f / WG8_SCALE;
#pragma unroll
        for (int ai = 0; ai < 2; ++ai)
#pragma unroll
            for (int m = 0; m < 4; ++m) {
#pragma unroll
                for (int bj = 0; bj < 2; ++bj) { const f32x4 v0 = acc[ai][bj][m][0] * SC + bv[bj][0], v1 = acc[ai][bj][m][1] * SC + bv[bj][1];
#define IG(x) (1.f + __builtin_amdgcn_exp2f(-1.4426950408889634f * (x)))
                    u32x4 w; w.x = cvt_pk_bf16(IG(v0[0]), IG(v0[1])); w.y = cvt_pk_bf16(IG(v0[2]), IG(v0[3])); w.z = cvt_pk_bf16(IG(v1[0]), IG(v1[1])); w.w = cvt_pk_bf16(IG(v1[2]), IG(v1[3]));
#undef IG
                    __builtin_nontemporal_store(w, &gdst[((ai * 4 + m) * 2 + bj) * 512]); } }
    }
};
struct EpiB {
    static constexpr bool PERM = true, CARRY = true;
    bf16_t* MG; const bf16_t* Gt;
    __device__ __forceinline__ void operator()(f32x4 (&acc)[2][2][4][2], const Unit& u, int wr, int wc, int fr, int fq) const {
        const int row0 = u.pm * 256 + wr * 64 + fr; const int colt = u.pn * 256 + wc * 32 + 8 * fq; const int seg = u.seg;
        const int t512 = (wr * 4 + wc) * 64 + fq * 16 + fr;
        const u32x4* gsrc = (const u32x4*)Gt + (size_t)(u.pm * 32 + seg * 8 + u.pn) * 8192 + t512;
        const u32x4* gnxt = gsrc + (size_t)8 * 8192;
#pragma unroll
        for (int ai = 0; ai < 2; ++ai) {
            u32x4 gw[8], gn[8];
#pragma unroll
            for (int j = 0; j < 8; ++j) gw[j] = __builtin_nontemporal_load(&gsrc[(ai * 8 + j) * 512]);
            if (seg < 3) {
#pragma unroll
                for (int j = 0; j < 8; ++j) gn[j] = __builtin_nontemporal_load(&gnxt[(ai * 8 + j) * 512]); }
#pragma unroll
            for (int m = 0; m < 4; ++m) { const size_t row = (size_t)(row0 + ai * 128 + m * 16);
#pragma unroll
                for (int bj = 0; bj < 2; ++bj) { const int j = m * 2 + bj;
                    const f32x4 a0 = acc[ai][bj][m][0], a1 = acc[ai][bj][m][1];
#define RG(x) __builtin_amdgcn_rcpf(x)
                    float v0 = a0[0] * RG(bflo(gw[j].x)), v1 = a0[1] * RG(bfhi(gw[j].x)), v2 = a0[2] * RG(bflo(gw[j].y)), v3 = a0[3] * RG(bfhi(gw[j].y));
                    float v4 = a1[0] * RG(bflo(gw[j].z)), v5 = a1[1] * RG(bfhi(gw[j].z)), v6 = a1[2] * RG(bflo(gw[j].w)), v7 = a1[3] * RG(bfhi(gw[j].w));
#undef RG
                    if (seg < 3) {
#define INVG(x) (x)
                        acc[ai][bj][m][0] = (f32x4){v0 * INVG(bflo(gn[j].x)), v1 * INVG(bfhi(gn[j].x)), v2 * INVG(bflo(gn[j].y)), v3 * INVG(bfhi(gn[j].y))};
                        acc[ai][bj][m][1] = (f32x4){v4 * INVG(bflo(gn[j].z)), v5 * INVG(bfhi(gn[j].z)), v6 * INVG(bflo(gn[j].w)), v7 * INVG(bfhi(gn[j].w))};
#undef INVG
                    } else {
                        u32x4 w; w.x = cvt_pk_bf16(v0, v1); w.y = cvt_pk_bf16(v2, v3); w.z = cvt_pk_bf16(v4, v5); w.w = cvt_pk_bf16(v6, v7);
                        *(u32x4*)(MG + row * DM + colt + bj * 128) = w; } } }
        }
    }
};
struct EpiRaw {
    static constexpr bool PERM = true, CARRY = false;
    bf16_t* O; int ldc;
    __device__ __forceinline__ void operator()(const f32x4 (&acc)[2][2][4][2], const Unit& u, int wr, int wc, int fr, int fq) const {
        const int row0 = u.pm * 256 + wr * 64 + fr; const int colt = u.pn * 256 + wc * 32 + 8 * fq;
#pragma unroll
        for (int ai = 0; ai < 2; ++ai)
#pragma unroll
            for (int m = 0; m < 4; ++m) { bf16_t* rowp = O + (size_t)(row0 + ai * 128 + m * 16) * ldc + colt;
#pragma unroll
                for (int bj = 0; bj < 2; ++bj) { const f32x4 v0 = acc[ai][bj][m][0], v1 = acc[ai][bj][m][1];
                    u32x4 w; w.x = cvt_pk_bf16(v0[0], v0[1]); w.y = cvt_pk_bf16(v0[2], v0[3]); w.z = cvt_pk_bf16(v1[0], v1[1]); w.w = cvt_pk_bf16(v1[2], v1[3]);
                    __builtin_nontemporal_store(w, (u32x4*)(rowp + bj * 128)); } }
    }
};
struct EpiSwiglu {
    static constexpr bool PERM = true, CARRY = false;
    bf16_t* ACT;
    __device__ __forceinline__ void operator()(const f32x4 (&acc)[2][2][4][2], const Unit& u, int wr, int wc, int fr, int fq) const {
        const int row0 = u.pm * 256 + wr * 64 + fr; const int colt = u.pn * 128 + wc * 32 + 8 * fq;
#pragma unroll
        for (int ai = 0; ai < 2; ++ai)
#pragma unroll
            for (int m = 0; m < 4; ++m) { const f32x4 g0 = acc[ai][0][m][0], g1 = acc[ai][0][m][1], u0 = acc[ai][1][m][0], u1 = acc[ai][1][m][1];
                u32x4 w;
                w.x = cvt_pk_bf16(g0[0] * sigmoidf_(g0[0]) * u0[0], g0[1] * sigmoidf_(g0[1]) * u0[1]);
                w.y = cvt_pk_bf16(g0[2] * sigmoidf_(g0[2]) * u0[2], g0[3] * sigmoidf_(g0[3]) * u0[3]);
                w.z = cvt_pk_bf16(g1[0] * sigmoidf_(g1[0]) * u1[0], g1[1] * sigmoidf_(g1[1]) * u1[1]);
                w.w = cvt_pk_bf16(g1[2] * sigmoidf_(g1[2]) * u1[2], g1[3] * sigmoidf_(g1[3]) * u1[3]);
                *(u32x4*)(ACT + (size_t)(row0 + ai * 128 + m * 16) * DFF + colt) = w; }
    }
};
}

namespace att {
constexpr int D = 128, NW = 8, QBLK = 32, KVBLK = 64;
constexpr float SCALE = 0.088388347648318440f;
constexpr float THR = 8.f;
constexpr int LDQ = 1024, LDK = 256, LDO = BRK;
constexpr size_t SHM_V = KVBLK * D * 2, SHM_K = KVBLK * D * 2, SHM_ATTN = 2 * SHM_V + 2 * SHM_K + NW * 64 * 4;
#define KSWZ(row, colB) ((row) * 256 + ((colB) ^ (((row) & 7) << 4)))
#define SBAR() __builtin_amdgcn_sched_barrier(0)
__device__ __forceinline__ int crow(int r, int hi) { return (r & 3) + 8 * (r >> 2) + 4 * hi; }
__device__ __forceinline__ void partialSM(f32x16& p0, f32x16& p1, float& m_reg, float& mn, float& alpha) {
  constexpr float C = SCALE * 1.4426950408889634f;
  float pmax = p0[0]; for (int r = 1; r < 16; ++r) pmax = fmaxf(pmax, p0[r]); for (int r = 0; r < 16; ++r) pmax = fmaxf(pmax, p1[r]);
  { auto rr = __builtin_amdgcn_permlane32_swap(__float_as_uint(pmax), __float_as_uint(pmax), false, false);
    pmax = fmaxf(__uint_as_float(rr[0]), __uint_as_float(rr[1])); }
  if (__builtin_expect(__all(pmax - m_reg <= THR / SCALE), 1)) { mn = m_reg; alpha = 1.f; }
  else { mn = fmaxf(m_reg, pmax); alpha = __builtin_amdgcn_exp2f((m_reg - mn) * C); m_reg = mn; }
  float mnC = -mn * C;
  for (int r = 0; r < 16; ++r) p0[r] = fmaf(p0[r], C, mnC); for (int r = 0; r < 16; ++r) p1[r] = fmaf(p1[r], C, mnC);
  for (int r = 0; r < 16; ++r) p0[r] = __builtin_amdgcn_exp2f(p0[r]);
}
__device__ __forceinline__ void finishSM(f32x16& p0, f32x16& p1, float alpha, float& l_reg, bf16x8& pa0, bf16x8& pa1, bf16x8& pa2, bf16x8& pa3) {
  for (int r = 0; r < 16; ++r) p1[r] = __builtin_amdgcn_exp2f(p1[r]);
  float ps = 0; for (int r = 0; r < 16; ++r) ps += p0[r]; for (int r = 0; r < 16; ++r) ps += p1[r];
  { auto rr = __builtin_amdgcn_permlane32_swap(__float_as_uint(ps), __float_as_uint(ps), false, false);
    ps = __uint_as_float(rr[0]) + __uint_as_float(rr[1]); }
  l_reg = l_reg * alpha + ps;
#define PK4(P, BASE, OUT) do { unsigned a0 = cvt_pk_bf16(P[BASE + 0], P[BASE + 1]), a1 = cvt_pk_bf16(P[BASE + 2], P[BASE + 3]);   \
    unsigned b0 = cvt_pk_bf16(P[BASE + 4], P[BASE + 5]), b1 = cvt_pk_bf16(P[BASE + 6], P[BASE + 7]);                              \
    auto r0 = __builtin_amdgcn_permlane32_swap(a0, b0, false, false); auto r1 = __builtin_amdgcn_permlane32_swap(a1, b1, false, false); \
    u32x4 w = {r0[0], r1[0], r0[1], r1[1]}; OUT = *reinterpret_cast<bf16x8*>(&w); } while (0)
  PK4(p0, 0, pa0); PK4(p0, 8, pa1); PK4(p1, 0, pa2); PK4(p1, 8, pa3);
#undef PK4
}
__device__ __forceinline__ void qkt(f32x16& p0, f32x16& p1, const bf16_t* Ks, const bf16x8* qr, int r32, int hi) {
  p0 = f32x16{}; p1 = f32x16{};
  for (int d0 = 0; d0 < 8; ++d0) { int cb = (d0 * 16 + hi * 8) * 2;
    bf16x8 b0 = *reinterpret_cast<const bf16x8*>((const char*)Ks + KSWZ(r32, cb));
    bf16x8 b1 = *reinterpret_cast<const bf16x8*>((const char*)Ks + KSWZ(32 + r32, cb));
    p0 = __builtin_amdgcn_mfma_f32_32x32x16_bf16(b0, qr[d0], p0, 0, 0, 0);
    p1 = __builtin_amdgcn_mfma_f32_32x32x16_bf16(b1, qr[d0], p1, 0, 0, 0); }
}
__device__ __forceinline__ int v_st(int k, int c) { const int kk = (k & ~0xC) | ((k & 4) << 1) | ((k & 8) >> 1); return ((kk >> 3) * 4 + (c >> 5)) * 512 + ((kk & 7) * 32 + (c & 31)) * 2; }
__device__ __forceinline__ int v_rd_base(int lane) { return ((lane & 3) << 3) | (((lane >> 2) & 3) << 6) | (((lane >> 4) & 1) << 5) | (((lane >> 5) & 1) << 8); }
constexpr int v_rd_off(int d0, int ks, int half) { return d0 * 512 + ks * 4096 + half * 2048; }
template <int OFF> __device__ __forceinline__ s16x4 tr_read(int vb) {
  s16x4 r; asm volatile("ds_read_b64_tr_b16 %0, %1 offset:%2" : "=&v"(r) : "v"(vb), "i"(OFF) : "memory"); return r;
}
template <int D0> __device__ __forceinline__ void pv_one(f32x16& od, int vb, bf16x8 pa0, bf16x8 pa1, bf16x8 pa2, bf16x8 pa3) {
  const s16x4 l0 = tr_read<v_rd_off(D0, 0, 0)>(vb), h0 = tr_read<v_rd_off(D0, 0, 1)>(vb), l1 = tr_read<v_rd_off(D0, 1, 0)>(vb), h1 = tr_read<v_rd_off(D0, 1, 1)>(vb);
  const s16x4 l2 = tr_read<v_rd_off(D0, 2, 0)>(vb), h2 = tr_read<v_rd_off(D0, 2, 1)>(vb), l3 = tr_read<v_rd_off(D0, 3, 0)>(vb), h3 = tr_read<v_rd_off(D0, 3, 1)>(vb);
  asm volatile("s_waitcnt lgkmcnt(0)" ::: "memory"); SBAR();
#define PK(L, H) (bf16x8){L[0], L[1], L[2], L[3], H[0], H[1], H[2], H[3]}
  od = __builtin_amdgcn_mfma_f32_32x32x16_bf16(pa0, PK(l0, h0), od, 0, 0, 0);
  od = __builtin_amdgcn_mfma_f32_32x32x16_bf16(pa1, PK(l1, h1), od, 0, 0, 0);
  od = __builtin_amdgcn_mfma_f32_32x32x16_bf16(pa2, PK(l2, h2), od, 0, 0, 0);
  od = __builtin_amdgcn_mfma_f32_32x32x16_bf16(pa3, PK(l3, h3), od, 0, 0, 0);
#undef PK
}
__device__ __forceinline__ void pv_d0(f32x16* o, int vb, bf16x8 pa0, bf16x8 pa1, bf16x8 pa2, bf16x8 pa3) {
  pv_one<0>(o[0], vb, pa0, pa1, pa2, pa3); pv_one<1>(o[1], vb, pa0, pa1, pa2, pa3); pv_one<2>(o[2], vb, pa0, pa1, pa2, pa3); pv_one<3>(o[3], vb, pa0, pa1, pa2, pa3);
}
__device__ __forceinline__ void attn_dense_body(const bf16_t* __restrict__ Qb, const bf16_t* __restrict__ Kh, const bf16_t* __restrict__ Vh,
                                                bf16_t* __restrict__ Ob, int seq, char* lds) {
  constexpr int SDEPTH = 2;
  const int tid = opaque_tid(), wid = tid >> 6, lane = tid & 63, r32 = lane & 31, hi = lane >> 5;
  bf16_t* V_lds = (bf16_t*)lds; bf16_t* K_lds = (bf16_t*)(lds + 2 * SHM_V);
  float* ws = (float*)(lds + 2 * SHM_V + 2 * SHM_K) + wid * 64; float* li_l = ws; float* al_l = ws + 32;
  float m_reg = -1e30f, l_reg = 0; f32x16 o[4] = {}; bf16x8 qr[8];
  const bf16_t* Qw = Qb + (long)(wid * QBLK + r32) * LDQ + hi * 8;
#pragma unroll
  for (int d0 = 0; d0 < 8; ++d0) qr[d0] = *reinterpret_cast<const bf16x8*>(Qw + d0 * 16);
  const int sr = tid >> 4, sc = (tid & 15) * 8, vst0 = v_st(sr, sc), vst1 = v_st(32 + sr, sc);
  const int vb0 = (int)(uintptr_t)V_lds + v_rd_base(lane);
  struct { bf16x8 vs0, vs1, ks0, ks1; } sr_[SDEPTH];
#define SLOAD(i, k0) do { sr_[i].vs0 = *reinterpret_cast<const bf16x8*>(&Vh[(long)((k0) + sr) * LDK + sc]); sr_[i].vs1 = *reinterpret_cast<const bf16x8*>(&Vh[(long)((k0) + 32 + sr) * LDK + sc]); \
    sr_[i].ks0 = *reinterpret_cast<const bf16x8*>(&Kh[(long)((k0) + sr) * LDK + sc]); sr_[i].ks1 = *reinterpret_cast<const bf16x8*>(&Kh[(long)((k0) + 32 + sr) * LDK + sc]); } while (0)
#define SWRITE(b, i) do { *(bf16x8*)((char*)V_lds + (b) * SHM_V + vst0) = sr_[i].vs0;          \
    *(bf16x8*)((char*)V_lds + (b) * SHM_V + vst1) = sr_[i].vs1; int kc = sc * 2;               \
    *(bf16x8*)((char*)K_lds + (b) * SHM_K + KSWZ(sr, kc)) = sr_[i].ks0;                       \
    *(bf16x8*)((char*)K_lds + (b) * SHM_K + KSWZ(32 + sr, kc)) = sr_[i].ks1; } while (0)
#define SWAIT() do { asm volatile("s_waitcnt vmcnt(4)" ::: "memory"); } while (0)
#define RESC(a) do { if (__any((a) < 1.f)) { if (hi == 0) al_l[r32] = (a); asm volatile("s_waitcnt lgkmcnt(0)" ::: "memory"); \
    for (int d = 0; d < 4; ++d) for (int r = 0; r < 16; ++r) o[d][r] *= al_l[crow(r, hi)]; } } while (0)
  f32x16 pA0, pA1, pB0, pB1; float mnA, mnB, alA, alB; bf16x8 pa0, pa1, pa2, pa3; const int NT = seq / KVBLK;
  constexpr int SE = 0, SO = SDEPTH - 1;
  SLOAD(SE, 0); asm volatile("s_waitcnt vmcnt(0)" ::: "memory"); SWRITE(0, SE); __syncthreads();
  qkt(pA0, pA1, K_lds, qr, r32, hi); partialSM(pA0, pA1, m_reg, mnA, alA);
  SLOAD(SO, KVBLK); if (2 < NT) SLOAD(SE, 2 * KVBLK);
  SWAIT(); SWRITE(1, SO); __syncthreads();
  for (int j = 1; j + 1 < NT; j += 2) {
    SBAR(); qkt(pB0, pB1, (bf16_t*)((char*)K_lds + SHM_K), qr, r32, hi);
    finishSM(pA0, pA1, alA, l_reg, pa0, pa1, pa2, pa3); SBAR();
    SLOAD(SO, (j + SDEPTH) * KVBLK); SBAR();
    pv_d0(o, vb0, pa0, pa1, pa2, pa3); partialSM(pB0, pB1, m_reg, mnB, alB);
    __syncthreads(); SWAIT(); SWRITE(0, SE);
    RESC(alB); __syncthreads();
    SBAR(); qkt(pA0, pA1, K_lds, qr, r32, hi);
    finishSM(pB0, pB1, alB, l_reg, pa0, pa1, pa2, pa3); SBAR();
    if (j + 3 < NT) SLOAD(SE, (j + 1 + SDEPTH) * KVBLK); SBAR();
    pv_d0(o, vb0 + (int)SHM_V, pa0, pa1, pa2, pa3); partialSM(pA0, pA1, m_reg, mnA, alA);
    __syncthreads(); SWAIT(); SWRITE(1, SO);
    RESC(alA); __syncthreads();
  }
  SBAR(); qkt(pB0, pB1, (bf16_t*)((char*)K_lds + SHM_K), qr, r32, hi);
  finishSM(pA0, pA1, alA, l_reg, pa0, pa1, pa2, pa3); SBAR();
  pv_d0(o, vb0, pa0, pa1, pa2, pa3); partialSM(pB0, pB1, m_reg, mnB, alB);
  __syncthreads(); RESC(alB);
  finishSM(pB0, pB1, alB, l_reg, pa0, pa1, pa2, pa3); SBAR();
  pv_d0(o, vb0 + (int)SHM_V, pa0, pa1, pa2, pa3);
  if (hi == 0) li_l[r32] = l_reg; asm volatile("s_waitcnt lgkmcnt(0)" ::: "memory");
  float rli[16];
#pragma unroll
  for (int r = 0; r < 16; ++r) rli[r] = __builtin_amdgcn_rcpf(li_l[crow(r, hi)]);
  bf16_t* Ow = Ob + (long)(wid * QBLK) * LDO;
#pragma unroll
  for (int r = 0; r < 16; ++r) { int orow = crow(r, hi);
    for (int d0 = 0; d0 < 4; ++d0) Ow[(long)orow * LDO + d0 * 32 + r32] = f2bf(o[d0][r] * rli[r]); }
  asm volatile("s_waitcnt vmcnt(0) lgkmcnt(0)" ::: "memory");
  __syncthreads();
#undef SLOAD
#undef SWRITE
#undef SWAIT
#undef RESC
}
#undef KSWZ
#undef SBAR
}

#define XB_TMO      128
#define XB_XCNT(j)  (256  + 64 * (j))
#define XB_XSUB(j)  (1280 + 64 * (j))
#define XB_XGEN(j)  (2304 + 64 * (j))
#define XB_TOP      3328
#define XB_TOPGEN   3392
#define XCD_BAR_WORDS 3456
#define XB_SPIN_CAP (1u << 18)
__device__ __forceinline__ unsigned xb_ld(unsigned* p)              { return __hip_atomic_load(p, __ATOMIC_RELAXED, __HIP_MEMORY_SCOPE_AGENT); }
__device__ __forceinline__ unsigned xb_add(unsigned* p, unsigned v) { return __hip_atomic_fetch_add(p, v, __ATOMIC_RELAXED, __HIP_MEMORY_SCOPE_AGENT); }
__device__ __forceinline__ unsigned xb_xcc_id() { return (unsigned)__builtin_amdgcn_s_getreg((3 << 11) | 20) & 0xFu; }
#define XB_SPIN(cond, bar) do { unsigned _sp = 0; while (cond) { __builtin_amdgcn_s_sleep(1); \
    if ((++_sp & 255u) == 0u) { if (xb_ld(&(bar)[XB_TMO])) break; if (_sp > XB_SPIN_CAP) { atomicAdd(&(bar)[XB_TMO], 1u); break; } } } } while (0)
struct XcdBarrier { unsigned* bar; unsigned x; volatile LAS unsigned* st; };
__device__ __forceinline__ XcdBarrier xcd_barrier_post(unsigned* bar, volatile LAS unsigned* st) {
    XcdBarrier b; b.bar = bar; b.x = xb_xcc_id(); b.st = st;
    if (threadIdx.x == 0) (void)xb_add(&bar[XB_XCNT(b.x)], 1u);
    return b;
}
__device__ __forceinline__ void xcd_barrier_complete(unsigned* bar, unsigned x, unsigned& nloc, unsigned& nx) {
    const unsigned G = gridDim.x * gridDim.y * gridDim.z;
    unsigned sum, cnt, mine, sp = 0u;
    for (;;) {
        sum = 0u; cnt = 0u; mine = 0u;
#pragma unroll
        for (unsigned j = 0; j < 16; ++j) { const unsigned c = xb_ld(&bar[XB_XCNT(j)]); sum += c; cnt += (c > 0u) ? 1u : 0u; mine = (j == x) ? c : mine; }
        if (sum == G) break;
        __builtin_amdgcn_s_sleep(1);
        if ((++sp & 255u) == 0u) { if (xb_ld(&bar[XB_TMO])) break; if (sp > XB_SPIN_CAP) { atomicAdd(&bar[XB_TMO], 1u); break; } }
    }
    nloc = mine > 0u ? mine : 1u; nx = cnt > 0u ? cnt : 1u;
}
__device__ __forceinline__ void xcd_barrier(const XcdBarrier& b) {
    asm volatile("s_waitcnt vmcnt(0)" ::: "memory");
    __syncthreads();
    if (threadIdx.x == 0) {
        unsigned* bar = b.bar;
        __builtin_amdgcn_s_waitcnt(0);
        unsigned nloc = b.st[0], nx = b.st[1];
        if (nloc == 0u) { xcd_barrier_complete(bar, b.x, nloc, nx); b.st[0] = nloc; b.st[1] = nx; }
        const unsigned old = xb_add(&bar[XB_XSUB(b.x)], 1u);
        const unsigned gen = old / nloc;
        if (old + 1u == (gen + 1u) * nloc) {
            __builtin_amdgcn_fence(__ATOMIC_RELEASE, "agent");
            asm volatile("s_waitcnt vmcnt(0)" ::: "memory");
            const unsigned og = xb_add(&bar[XB_TOP], 1u);
            const unsigned tg = og / nx;
            if (og + 1u == (tg + 1u) * nx) xb_add(&bar[XB_TOPGEN], 1u);
            else XB_SPIN(xb_ld(&bar[XB_TOPGEN]) == tg, bar);
            __builtin_amdgcn_fence(__ATOMIC_ACQUIRE, "agent");
            xb_add(&bar[XB_XGEN(b.x)], 1u);
            asm volatile("s_waitcnt vmcnt(0)" ::: "memory");
        } else {
            XB_SPIN(xb_ld(&bar[XB_XGEN(b.x)]) == gen, bar);
            __builtin_amdgcn_fence(__ATOMIC_ACQUIRE, "agent");
            asm volatile("s_waitcnt vmcnt(0)" ::: "memory");
        }
    }
    __syncthreads();
}

struct Args { const float* in[30]; float* out; unsigned char* ws; int ph_lo, ph_hi; };
enum { I_X = 0, I_C, I_CTX, I_CCTX, I_WADA, I_BADA, I_WIN, I_QG, I_KG, I_POOLW, I_POOLS, I_SLNG, I_SLNB, I_SGUW, I_SGUB, I_CONVW,
       I_WBRA, I_WBRP, I_WBRS, I_WBRC, I_WGATE, I_BGATE, I_WO, I_LN1G, I_LN1B, I_WFG, I_WFU, I_WFD, I_LN2G, I_LN2B };

__device__ __forceinline__ void phase_mods(const Args& a, char* lds, int G) {
    const int tid = opaque_tid();
    float* sc = (float*)lds;
    float* red = (float*)(lds + 9 * 2048 * 4);
    for (int i = tid; i < 9 * 2048; i += 512) { const int r = i >> 11, k = i & 2047; const float v = r < 8 ? a.in[I_C][r * 2048 + k] : a.in[I_CCTX][k]; sc[i] = v * sigmoidf_(v); }
    __syncthreads();
    float* mod = (float*)(a.ws + WS_MOD);
    const int lane = tid & 63, wave = tid >> 6, c4 = (lane & 15) * 4, kr = lane >> 4;
    for (int it = blockIdx.x; it < 2 * (MODW / 64); it += G) {
        const int l = it / (MODW / 64), n0 = (it % (MODW / 64)) * 64;
        const float* W = a.in[I_WADA] + (size_t)l * DM * MODW + n0 + c4;
        f32x4 acc[9];
#pragma unroll
        for (int r = 0; r < 9; ++r) acc[r] = (f32x4){0.f, 0.f, 0.f, 0.f};
#pragma unroll 8
        for (int i = 0; i < 64; ++i) { const int k = wave * 256 + i * 4 + kr; const f32x4 w = __builtin_nontemporal_load((const f32x4*)(W + (size_t)k * MODW));
#pragma unroll
            for (int r = 0; r < 9; ++r) acc[r] += w * sc[r * 2048 + k]; }
#pragma unroll
        for (int r = 0; r < 9; ++r)
#pragma unroll
            for (int e = 0; e < 4; ++e) { float v = acc[r][e]; v += __shfl_xor(v, 16); v += __shfl_xor(v, 32); acc[r][e] = v; }
        if (kr == 0) {
#pragma unroll
            for (int r = 0; r < 9; ++r) *(f32x4*)(red + (wave * 9 + r) * 64 + c4) = acc[r]; }
        __syncthreads();
        for (int i = tid; i < 9 * 64; i += 512) { const int r = i >> 6, cc = i & 63; float sm = 0.f;
#pragma unroll
            for (int g = 0; g < 8; ++g) sm += red[(g * 9 + r) * 64 + cc];
            mod[((size_t)l * 9 + r) * MODW + n0 + cc] = sm + a.in[I_BADA][l * MODW + n0 + cc]; }
        __syncthreads();
    }
    if (blockIdx.x == G - 1) {
        float* rope = (float*)(a.ws + WS_ROPE);
        for (int i = tid; i < 64 * 32; i += 512) { const int pos = i >> 5, j = i & 31;
            const float inv = exp2f(-(float)(2 * j) / 64.f * 13.287712379549449f);
            const float ang = (float)pos * inv; const float turns = ang * 0.15915494309189535f; const float fr = turns - floorf(turns);
            rope[2 * i] = __builtin_amdgcn_cosf(fr); rope[2 * i + 1] = __builtin_amdgcn_sinf(fr); }
    }
}

__device__ __forceinline__ void tr_item(const float* W, int N, bf16_t* WT, int ldd, int drow0, int dk0, int k0, int n0, float* scr, int lane) {
    { const int r = lane >> 3, c4 = (lane & 7) * 4; f32x4 v[8];
#pragma unroll
        for (int i = 0; i < 8; ++i) v[i] = __builtin_nontemporal_load((const f32x4*)(W + (size_t)(k0 + r + 8 * i) * N + n0 + c4));
#pragma unroll
        for (int i = 0; i < 8; ++i) { float* d = scr + (r + 8 * i) * 33 + c4; d[0] = v[i][0]; d[1] = v[i][1]; d[2] = v[i][2]; d[3] = v[i][3]; } }
    LDS_WAIT(); asm volatile("" ::: "memory");
    const int c = lane & 7;
#pragma unroll
    for (int j = 0; j < 4; ++j) { const int n = (lane >> 3) + 8 * j; const float* s = scr + (8 * c) * 33 + n;
        u32x4 o; o.x = cvt_pk_bf16(s[0 * 33], s[1 * 33]); o.y = cvt_pk_bf16(s[2 * 33], s[3 * 33]); o.z = cvt_pk_bf16(s[4 * 33], s[5 * 33]); o.w = cvt_pk_bf16(s[6 * 33], s[7 * 33]);
        *(u32x4*)(WT + (size_t)(drow0 + n0 + n) * ldd + dk0 + k0 + 8 * c) = o; }
    LDS_WAIT(); asm volatile("" ::: "memory");
}
__device__ __forceinline__ void tr_item8(const float* W, int N, unsigned char* WT, int k0, int n0, float* scr, int lane) {
    { const int r = lane >> 3, c4 = (lane & 7) * 4; f32x4 v[8];
#pragma unroll
        for (int i = 0; i < 8; ++i) v[i] = __builtin_nontemporal_load((const f32x4*)(W + (size_t)(k0 + r + 8 * i) * N + n0 + c4));
#pragma unroll
        for (int i = 0; i < 8; ++i) { float* d = scr + (r + 8 * i) * 33 + c4; d[0] = v[i][0]; d[1] = v[i][1]; d[2] = v[i][2]; d[3] = v[i][3]; } }
    LDS_WAIT(); asm volatile("" ::: "memory");
    const int c = lane & 7;
#pragma unroll
    for (int j = 0; j < 4; ++j) { const int n = (lane >> 3) + 8 * j; const float* sp = scr + (8 * c) * 33 + n;
        unsigned lo = 0, hi = 0;
        lo = __builtin_amdgcn_cvt_pk_fp8_f32(sp[0 * 33] * WG8_SCALE, sp[1 * 33] * WG8_SCALE, lo, false); lo = __builtin_amdgcn_cvt_pk_fp8_f32(sp[2 * 33] * WG8_SCALE, sp[3 * 33] * WG8_SCALE, lo, true);
        hi = __builtin_amdgcn_cvt_pk_fp8_f32(sp[4 * 33] * WG8_SCALE, sp[5 * 33] * WG8_SCALE, hi, false); hi = __builtin_amdgcn_cvt_pk_fp8_f32(sp[6 * 33] * WG8_SCALE, sp[7 * 33] * WG8_SCALE, hi, true);
        u32x2 o; o.x = lo; o.y = hi;
        *(u32x2*)(WT + (size_t)(n0 + n) * 4096 + k0 + 8 * c) = o; }
    LDS_WAIT(); asm volatile("" ::: "memory");
}
constexpr int PI1 = 32 * 144, PI2 = 32 * 256, PI3 = 16 * 64, PI4 = 8 * 64, PI5 = 8 * 64, PI6 = 32 * 64, PI7 = 32 * 176, PI8 = 32 * 176, PI9 = 88 * 64;
constexpr int PNIT = PI1 + PI2 + PI3 + PI4 + PI5 + PI6 + PI7 + PI8 + PI9, PIT_WA = PI1 + PI2, PIT_WE = PNIT - PI9;
__device__ __forceinline__ void prep_items(const Args& a, char* lds, int l, int it_lo, int it_hi, int wk, int nw) {
    const int tid = opaque_tid(), lane = tid & 63, wave = tid >> 6;
    float* scr = (float*)(lds + wave * 16384);
    bf16_t* WA = (bf16_t*)(a.ws + WS_WA); bf16_t* WB = (bf16_t*)(a.ws + WS_WB); bf16_t* WC = (bf16_t*)(a.ws + WS_WC);
    bf16_t* WD = (bf16_t*)(a.ws + WS_WD); bf16_t* WE = (bf16_t*)(a.ws + WS_WE);
    for (int it = it_lo + wk; it < it_hi; it += nw) {
        int r = it;
        if (r < PI1) { const int nb = r % 144, kb = r / 144; tr_item(a.in[I_WIN] + (size_t)l * DM * INW, INW, WA, DM, 0, 0, kb * 64, nb * 32, scr, lane); continue; } r -= PI1;
        if (r < PI2) { const int nb = r % 256, kb = r / 256; tr_item8(a.in[I_WGATE] + (size_t)l * DM * GW, GW, (unsigned char*)(a.ws + WS_WG8), kb * 64, nb * 32, scr, lane); continue; } r -= PI2;
        if (r < PI3) { const int nb = r % 64, kb = r / 64; tr_item(a.in[I_WBRA] + (size_t)l * 1024 * DM, DM, WB, BRK, 0, 0, kb * 64, nb * 32, scr, lane); continue; } r -= PI3;
        if (r < PI4) { const int nb = r % 64, kb = r / 64; tr_item(a.in[I_WBRS] + (size_t)l * 512 * DM, DM, WB, BRK, 0, 1536, kb * 64, nb * 32, scr, lane); continue; } r -= PI4;
        if (r < PI5) { const int nb = r % 64, kb = r / 64; tr_item(a.in[I_WBRC] + (size_t)l * 512 * DM, DM, WB, BRK, 0, 2048, kb * 64, nb * 32, scr, lane); continue; } r -= PI5;
        if (r < PI6) { const int nb = r % 64, kb = r / 64; tr_item(a.in[I_WO] + (size_t)l * DM * DM, DM, WC, DM, 0, 0, kb * 64, nb * 32, scr, lane); continue; } r -= PI6;
        if (r < PI7) { const int nb = r % 176, kb = r / 176; const int n0 = nb * 32; tr_item(a.in[I_WFG] + (size_t)l * DM * DFF, DFF, WD, DM, (n0 >> 7) * 256 + (n0 & 127) - n0, 0, kb * 64, n0, scr, lane); continue; } r -= PI7;
        if (r < PI8) { const int nb = r % 176, kb = r / 176; const int n0 = nb * 32; tr_item(a.in[I_WFU] + (size_t)l * DM * DFF, DFF, WD, DM, (n0 >> 7) * 256 + 128 + (n0 & 127) - n0, 0, kb * 64, n0, scr, lane); continue; } r -= PI8;
        { const int nb = r % 64, kb = r / 64; tr_item(a.in[I_WFD] + (size_t)l * DFF * DM, DM, WE, DFF, 0, 0, kb * 64, nb * 32, scr, lane); }
    }
}
__device__ __forceinline__ void prep_poolfold(const Args& a, int l, int wg, int nwg) {
    const int tid = opaque_tid();
    bf16_t* WB = (bf16_t*)(a.ws + WS_WB);
    const float* pw = a.in[I_POOLW] + (size_t)l * 4 * 128 * 128; const float* ps = a.in[I_POOLS] + (size_t)l * 512; const float* wbp = a.in[I_WBRP] + (size_t)l * 512 * DM;
    for (int it = wg; it < 128; it += nwg) {
        const int g = it >> 5, n = (it & 31) * 64 + (tid & 63), k16 = (tid >> 6) * 16;
        float acc[16];
#pragma unroll
        for (int q = 0; q < 16; ++q) acc[q] = 0.f;
        for (int j = 0; j < 128; ++j) { const float w = wbp[(size_t)(g * 128 + j) * DM + n] * ps[g * 128 + j];
#pragma unroll
            for (int q = 0; q < 16; ++q) acc[q] += pw[((size_t)g * 128 + k16 + q) * 128 + j] * w; }
        u32x4 o0, o1;
        o0.x = cvt_pk_bf16(acc[0], acc[1]); o0.y = cvt_pk_bf16(acc[2], acc[3]); o0.z = cvt_pk_bf16(acc[4], acc[5]); o0.w = cvt_pk_bf16(acc[6], acc[7]);
        o1.x = cvt_pk_bf16(acc[8], acc[9]); o1.y = cvt_pk_bf16(acc[10], acc[11]); o1.z = cvt_pk_bf16(acc[12], acc[13]); o1.w = cvt_pk_bf16(acc[14], acc[15]);
        bf16_t* dst = WB + (size_t)n * BRK + 1024 + g * 128 + k16;
        *(u32x4*)dst = o0; *(u32x4*)(dst + 8) = o1;
    }
}

__device__ __forceinline__ void phase_rows(const Args& a, int G, int mode, int nrows, const float* lng, const float* lnb, const float* modg, int goff,
                                           const float* xl_src, const float* xc_src, const float* modh, int sh_off, int sc_off, float* xl_out, bool w8) {
    unsigned char* H8 = a.ws + WS_H8;
    const int tid = opaque_tid(), lane = tid & 63, wave = tid >> 6;
    const int gw = blockIdx.x * 8 + wave, NGW = G * 8;
    const bf16_t* MB = (const bf16_t*)(a.ws + WS_P); float* xc_out = (float*)(a.ws + WS_XC); bf16_t* H = (bf16_t*)(a.ws + WS_H);
    f32x4 lg_[8], lb_[8];
    if (mode != 0) {
#pragma unroll
        for (int j = 0; j < 8; ++j) { const int c = 4 * (lane + 64 * j); lg_[j] = *(const f32x4*)(lng + c); lb_[j] = *(const f32x4*)(lnb + c); } }
    f32x4 v[8];
    if (gw < nrows) { const float* src = gw < ML ? xl_src + (size_t)gw * DM : xc_src + (size_t)(gw - ML) * DM;
#pragma unroll
        for (int j = 0; j < 8; ++j) v[j] = __builtin_nontemporal_load((const f32x4*)(src + 4 * (lane + 64 * j))); }
    for (int m = gw; m < nrows; m += NGW) {
        const int mrow = m < ML ? (m >> 11) : 8;
        f32x4 scv[8], shv[8];
        if (mode != 2) { const float* mr = modh + (size_t)mrow * MODW;
#pragma unroll
            for (int j = 0; j < 8; ++j) { const int c = 4 * (lane + 64 * j); scv[j] = *(const f32x4*)(mr + sc_off + c); shv[j] = *(const f32x4*)(mr + sh_off + c); } }
        if (mode != 0) {
            const bf16_t* mb = MB + (size_t)m * DM; const float* gr = modg + (size_t)mrow * MODW + goff;
            float s = 0.f;
#pragma unroll
            for (int j = 0; j < 8; ++j) { const int c = 4 * (lane + 64 * j); const u32x2 w = __builtin_nontemporal_load((const u32x2*)(mb + c)); const f32x4 g = *(const f32x4*)(gr + c);
                const f32x4 mv = {bflo(w.x), bfhi(w.x), bflo(w.y), bfhi(w.y)};
                v[j] = v[j] * ALPHA + g * mv; s += (v[j][0] + v[j][1]) + (v[j][2] + v[j][3]); }
            const float mean = wave_sum(s) * (1.f / DM); float s2 = 0.f;
#pragma unroll
            for (int j = 0; j < 8; ++j) { v[j] = v[j] - mean; s2 += (v[j][0] * v[j][0] + v[j][1] * v[j][1]) + (v[j][2] * v[j][2] + v[j][3] * v[j][3]); }
            const float rstd = 1.f / sqrtf(wave_sum(s2) * (1.f / DM) + LN_EPS);
#pragma unroll
            for (int j = 0; j < 8; ++j) v[j] = v[j] * rstd * lg_[j] + lb_[j];
        }
        const int mn = m + NGW; f32x4 vn[8];
        if (mn < nrows) { const float* srcn = mn < ML ? xl_src + (size_t)mn * DM : xc_src + (size_t)(mn - ML) * DM;
#pragma unroll
            for (int j = 0; j < 8; ++j) vn[j] = __builtin_nontemporal_load((const f32x4*)(srcn + 4 * (lane + 64 * j))); }
        if (mode != 0) { float* xo = m < ML ? xl_out + (size_t)m * DM : xc_out + (size_t)(m - ML) * DM;
#pragma unroll
            for (int j = 0; j < 8; ++j) __builtin_nontemporal_store(v[j], (f32x4*)(xo + 4 * (lane + 64 * j))); }
        if (mode != 2) {
#pragma unroll
            for (int j = 0; j < 8; ++j) { const int c = 4 * (lane + 64 * j);
                const f32x4 h = v[j] * (scv[j] + 1.f) + shv[j]; u32x2 w; w.x = cvt_pk_bf16(h[0], h[1]); w.y = cvt_pk_bf16(h[2], h[3]);
                *(u32x2*)(H + (size_t)m * DM + c) = w;
                if (w8) { unsigned q = 0; q = __builtin_amdgcn_cvt_pk_fp8_f32(h[0], h[1], q, false); q = __builtin_amdgcn_cvt_pk_fp8_f32(h[2], h[3], q, true); *(unsigned*)(H8 + (size_t)m * 4096 + c) = q; } }
        }
        if (mn < nrows) {
#pragma unroll
            for (int j = 0; j < 8; ++j) v[j] = vn[j]; }
    }
}

__device__ __forceinline__ void unpack8(const u32x4 w, float* f) { f[0] = bflo(w.x); f[1] = bfhi(w.x); f[2] = bflo(w.y); f[3] = bfhi(w.y); f[4] = bflo(w.z); f[5] = bfhi(w.z); f[6] = bflo(w.w); f[7] = bfhi(w.w); }
__device__ __forceinline__ u32x4 pack8(const float* f) { u32x4 w; w.x = cvt_pk_bf16(f[0], f[1]); w.y = cvt_pk_bf16(f[2], f[3]); w.z = cvt_pk_bf16(f[4], f[5]); w.w = cvt_pk_bf16(f[6], f[7]); return w; }

__device__ __forceinline__ void phase_local(const Args& a, char* lds, int G, int l) {
    const int tid = opaque_tid(), lane = tid & 63, wave = tid >> 6;
    const bf16_t* P = (const bf16_t*)(a.ws + WS_P); bf16_t* BR = (bf16_t*)(a.ws + WS_BR); bf16_t* QB = (bf16_t*)(a.ws + WS_QB);
    bf16_t* KB = (bf16_t*)(a.ws + WS_KB); bf16_t* VB = (bf16_t*)(a.ws + WS_VB);
    const float* rope = (const float*)(a.ws + WS_ROPE);
    const float* qg = a.in[I_QG] + l * 128; const float* kg = a.in[I_KG] + l * 128;
    const float* slng = a.in[I_SLNG] + l * 512; const float* slnb = a.in[I_SLNB] + l * 512;
    const float* sguw = a.in[I_SGUW] + (size_t)l * 4 * 128 * 128; const float* sgub = a.in[I_SGUB] + l * 512;
    const float* convw = a.in[I_CONVW] + l * 3 * 512;
    const bool last = (l == 1);
    const int nfull = last ? 128 : 144;
    const int nitems = nfull * 7 + (last ? 16 : 0);
    for (int it = blockIdx.x; it < nitems; it += G) {
        int ci, task;
        if (it < nfull * 7) { task = it / nfull; ci = it % nfull; } else { task = 0; ci = 128 + (it - nfull * 7); }
        int b, t0, n, m0;
        if (ci < 128) { b = ci >> 4; t0 = (ci & 15) * 128; n = SEQ; m0 = ci * 128; }
        else { const int cj = ci - 128; b = cj >> 1; t0 = (cj & 1) * 128; n = CTXL; m0 = ML + cj * 128; }
        const bool isctx = ci >= 128;
        if (task == 0) {
            const int hs = lane >> 4, i16 = lane & 15, e0 = i16 * 8;
            float gq[8], gk[8];
#pragma unroll
            for (int e = 0; e < 8; ++e) { gq[e] = qg[e0 + e]; gk[e] = kg[e0 + e]; }
            const bool lower = (i16 & 4) == 0;
            const int hg0 = (isctx && last) ? 2 : 0;
            for (int i = 0; i < 16; i += 2) {
                u32x4 raw[2][3], vraw[2]; f32x4 rp[2][4];
#pragma unroll
                for (int tk = 0; tk < 2; ++tk) { const size_t m = (size_t)m0 + wave * 16 + i + tk; const bf16_t* pr = P + m * INW;
#pragma unroll
                    for (int hg = 0; hg < 3; ++hg) if (hg >= hg0) raw[tk][hg] = *(const u32x4*)(pr + (hg * 4 + hs) * 128 + e0);
                    vraw[tk] = *(const u32x4*)(pr + 1280 + (lane & 31) * 8);
                    if (!isctx) { const int t = t0 + wave * 16 + i + tk; const int pos = i16 < 8 ? (t >> 6) : (t & 63); const float* rr = rope + (pos * 32 + 8 * (i16 & 3)) * 2;
#pragma unroll
                        for (int q = 0; q < 4; ++q) rp[tk][q] = *(const f32x4*)(rr + 4 * q); } }
#pragma unroll
                for (int tk = 0; tk < 2; ++tk) { const int tt = wave * 16 + i + tk, t = t0 + tt; const size_t m = (size_t)m0 + tt;
                    const int kvpos = isctx ? t : CTXL + t; const size_t kvrow = ((size_t)b * KVLEN + kvpos) * 256;
#pragma unroll
                    for (int hg = 0; hg < 3; ++hg) if (hg >= hg0) {
                        const int head = hg * 4 + hs;
                        float x[8]; unpack8(raw[tk][hg], x);
                        float ss = 0.f;
#pragma unroll
                        for (int e = 0; e < 8; ++e) ss += x[e] * x[e];
                        ss += __shfl_xor(ss, 1); ss += __shfl_xor(ss, 2); ss += __shfl_xor(ss, 4); ss += __shfl_xor(ss, 8);
                        const float r = 1.f / sqrtf(ss * (1.f / 128.f) + RMS_EPS);
                        float o[8];
#pragma unroll
                        for (int e = 0; e < 8; ++e) o[e] = x[e] * r * (hg < 2 ? gq[e] : gk[e]);
                        if (!isctx) {
#pragma unroll
                            for (int e = 0; e < 8; ++e) { const float pn = __shfl_xor(o[e], 4); const float cs = rp[tk][e >> 1][(e & 1) * 2], sn = rp[tk][e >> 1][(e & 1) * 2 + 1];
                                o[e] = lower ? o[e] * cs - pn * sn : o[e] * cs + pn * sn; } }
                        if (hg < 2) *(u32x4*)(QB + m * 1024 + head * 128 + e0) = pack8(o);
                        else if (hs < 2) *(u32x4*)(KB + kvrow + hs * 128 + e0) = pack8(o);
                    }
                    if (lane < 32) *(u32x4*)(VB + kvrow + lane * 8) = vraw[tk];
                }
            }
        } else if (task == 1) {
            const int g = wave >> 1, vec = lane & 15, sub = (lane >> 4) + 4 * (wave & 1), ch0 = g * 128 + vec * 8;
            const int w = 2 << g, left = w >> 1;
            const bf16_t* zb = P + ((size_t)m0 - t0) * INW + 1536 + ch0;
            for (int k = 0; k < 16; ++k) { const int tt = k * 8 + sub, t = t0 + tt;
                const u32x4 zc = *(const u32x4*)(zb + (size_t)t * INW);
                float s[8] = {0.f, 0.f, 0.f, 0.f, 0.f, 0.f, 0.f, 0.f}, z[8], f[8]; int cnt = 0;
#pragma unroll
                for (int hq = 0; hq < 16; hq += 8) if (hq < w) {
                    u32x4 rw[8];
#pragma unroll
                    for (int q = 0; q < 8; ++q) { int row = t - left + hq + q; row = row < 0 ? 0 : (row > n - 1 ? n - 1 : row); if (hq + q < w) rw[q] = *(const u32x4*)(zb + (size_t)row * INW); }
#pragma unroll
                    for (int q = 0; q < 8; ++q) if (hq + q < w) { const int row = t - left + hq + q; if (row >= 0 && row < n) { unpack8(rw[q], f); ++cnt;
#pragma unroll
                            for (int e = 0; e < 8; ++e) s[e] += f[e]; } } }
                unpack8(zc, z);
                const float inv = 1.f / (float)cnt;
#pragma unroll
                for (int e = 0; e < 8; ++e) f[e] = s[e] * inv - z[e];
                *(u32x4*)(BR + ((size_t)m0 + tt) * BRK + 1024 + ch0) = pack8(f); }
        } else if (task == 2) {
            float cw0[8], cw1[8], cw2[8]; const int vecc = tid & 63, chc = vecc * 8;
#pragma unroll
            for (int e = 0; e < 8; ++e) { cw0[e] = convw[chc + e]; cw1[e] = convw[512 + chc + e]; cw2[e] = convw[1024 + chc + e]; }
            for (int k = 0; k < 16; k += 2) {
                u32x4 ld[2][7];
#pragma unroll
                for (int u = 0; u < 2; ++u) { const int tt = (tid >> 6) + 8 * (k + u), t = t0 + tt; const bf16_t* pr = P + ((size_t)m0 + tt) * INW;
                    const bf16_t* pm = t > 0 ? pr - INW : pr; const bf16_t* pp = t < n - 1 ? pr + INW : pr;
                    ld[u][0] = *(const u32x4*)(pr + 3072 + chc); ld[u][1] = *(const u32x4*)(pr + 3584 + chc); ld[u][2] = *(const u32x4*)(pr + 4096 + chc);
                    ld[u][3] = *(const u32x4*)(pm + 3584 + chc); ld[u][4] = *(const u32x4*)(pm + 4096 + chc);
                    ld[u][5] = *(const u32x4*)(pp + 3584 + chc); ld[u][6] = *(const u32x4*)(pp + 4096 + chc); }
#pragma unroll
                for (int u = 0; u < 2; ++u) { const int tt = (tid >> 6) + 8 * (k + u), t = t0 + tt;
                    float cb[8], cc[8], cx[8], a1[8], a2[8], b1[8], b2[8], f[8];
                    unpack8(ld[u][0], cb); unpack8(ld[u][1], cc); unpack8(ld[u][2], cx); unpack8(ld[u][3], a1); unpack8(ld[u][4], a2); unpack8(ld[u][5], b1); unpack8(ld[u][6], b2);
                    const float mm = t > 0 ? 1.f : 0.f, mp = t < n - 1 ? 1.f : 0.f;
#pragma unroll
                    for (int e = 0; e < 8; ++e) f[e] = cb[e] * ((a1[e] * a2[e]) * (mm * cw0[e]) + (cc[e] * cx[e]) * cw1[e] + (b1[e] * b2[e]) * (mp * cw2[e]));
                    *(u32x4*)(BR + ((size_t)m0 + tt) * BRK + 2048 + chc) = pack8(f); }
            }
        } else {
            const int g = task - 3;
            bf16_t* Vt = (bf16_t*)lds;
            bf16_t* Ws = (bf16_t*)(lds + 128 * 272);
            u32x4 vr[16];
#pragma unroll
            for (int i = 0; i < 16; ++i) vr[i] = *(const u32x4*)(P + ((size_t)m0 + wave * 16 + i) * INW + 2560 + lane * 8);
            float lg[8], lb[8];
            { const int c0 = (lane & 15) * 8;
#pragma unroll
                for (int e = 0; e < 8; ++e) { lg[e] = slng[g * 128 + c0 + e]; lb[e] = slnb[g * 128 + c0 + e]; } }
#pragma unroll
            for (int i = 0; i < 16; ++i) { const int q = wave * 16 + i; float f[8];
                unpack8(vr[i], f);
                float s = 0.f;
#pragma unroll
                for (int e = 0; e < 8; ++e) { f[e] = gelu_tanh(f[e]); s += f[e]; }
                const float mean = wave_sum(s) * (1.f / 512.f); float s2 = 0.f;
#pragma unroll
                for (int e = 0; e < 8; ++e) { f[e] -= mean; s2 += f[e] * f[e]; }
                const float rstd = 1.f / sqrtf(wave_sum(s2) * (1.f / 512.f) + LN_EPS);
                if ((lane >> 4) == g) { const int c0 = (lane & 15) * 8;
#pragma unroll
                    for (int e = 0; e < 8; ++e) Vt[(c0 + e) * 136 + q] = f2bf(f[e] * rstd * lg[e] + lb[e]); } }
            { const int p = tid >> 2, q0 = (tid & 3) * 32; const float* wsrc = sguw + ((size_t)g * 128 + p) * 128 + q0;
#pragma unroll
                for (int k = 0; k < 4; ++k) { const f32x4 x0 = *(const f32x4*)(wsrc + 8 * k), x1 = *(const f32x4*)(wsrc + 8 * k + 4);
                    u32x4 w; w.x = cvt_pk_bf16(x0[0], x0[1]); w.y = cvt_pk_bf16(x0[2], x0[3]); w.z = cvt_pk_bf16(x1[0], x1[1]); w.w = cvt_pk_bf16(x1[2], x1[3]);
                    *(u32x4*)(Ws + p * 136 + q0 + 8 * k) = w; } }
            __syncthreads();
            f32x4 acc[8]; u32x2 uw[8];
            { const int p = 16 * wave + (lane & 15); const size_t m = (size_t)m0 + p;
#pragma unroll
                for (int i = 0; i < 8; ++i) uw[i] = *(const u32x2*)(P + m * INW + 2048 + g * 128 + 16 * i + 4 * (lane >> 4)); }
#pragma unroll
            for (int i = 0; i < 8; ++i) acc[i] = (f32x4){0.f, 0.f, 0.f, 0.f};
#pragma unroll
            for (int kk = 0; kk < 4; ++kk) { const bf16x8 bw = *(const bf16x8*)(Ws + (16 * wave + (lane & 15)) * 136 + kk * 32 + (lane >> 4) * 8);
#pragma unroll
                for (int i = 0; i < 8; ++i) { const bf16x8 av = *(const bf16x8*)(Vt + (16 * i + (lane & 15)) * 136 + kk * 32 + (lane >> 4) * 8);
                    acc[i] = __builtin_amdgcn_mfma_f32_16x16x32_bf16(av, bw, acc[i], 0, 0, 0); } }
            { const int p = 16 * wave + (lane & 15); const size_t m = (size_t)m0 + p; const float bias = sgub[g * 128 + p];
#pragma unroll
                for (int i = 0; i < 8; ++i) { const int c = 16 * i + 4 * (lane >> 4);
                    const float y0 = gelu_tanh(bflo(uw[i].x)) * (acc[i][0] + bias), y1 = gelu_tanh(bfhi(uw[i].x)) * (acc[i][1] + bias);
                    const float y2 = gelu_tanh(bflo(uw[i].y)) * (acc[i][2] + bias), y3 = gelu_tanh(bfhi(uw[i].y)) * (acc[i][3] + bias);
                    u32x2 w; w.x = cvt_pk_bf16(y0, y1); w.y = cvt_pk_bf16(y2, y3);
                    *(u32x2*)(BR + m * BRK + 1536 + g * 128 + c) = w; } }
            __syncthreads();
        }
    }
}

__device__ __forceinline__ void phase_attn(const Args& a, char* lds, int G, int l) {
    const bf16_t* QB = (const bf16_t*)(a.ws + WS_QB); const bf16_t* KB = (const bf16_t*)(a.ws + WS_KB); const bf16_t* VB = (const bf16_t*)(a.ws + WS_VB);
    bf16_t* BR = (bf16_t*)(a.ws + WS_BR);
    const int c = blockIdx.x;
    for (int i = 0; i * G + c < 512; ++i) {
        int b, h, qb;
        if (G == 256) { const int grp = (c & 7) + 8 * i, j = c >> 3; b = grp >> 1; h = (grp & 1) * 4 + (j >> 3); qb = j & 7; }
        else { const int u = i * G + c; b = u >> 6; h = (u >> 3) & 7; qb = u & 7; }
        const size_t qrow = (size_t)b * SEQ + qb * 256;
        att::attn_dense_body(QB + qrow * 1024 + h * 128, KB + (size_t)b * KVLEN * 256 + (h >> 2) * 128, VB + (size_t)b * KVLEN * 256 + (h >> 2) * 128,
                             BR + qrow * BRK + h * 128, KVLEN, lds);
    }
    if (l == 0) for (int u = c; u < 64; u += G) {
        const int b = u >> 3, h = u & 7; const size_t qrow = (size_t)ML + b * CTXL;
        att::attn_dense_body(QB + qrow * 1024 + h * 128, KB + (size_t)b * KVLEN * 256 + (h >> 2) * 128, VB + (size_t)b * KVLEN * 256 + (h >> 2) * 128,
                             BR + qrow * BRK + h * 128, CTXL, lds);
    }
}

constexpr int NPHASE = 20;
__global__ void __launch_bounds__(512, 2) mega_fwd(Args a) {
    extern __shared__ __attribute__((aligned(16))) unsigned char lds[];
    const int G = gridDim.x, c = blockIdx.x;
    LAS unsigned char* ldsl = (LAS unsigned char*)lds;
    float* modb = (float*)(a.ws + WS_MOD);
    volatile LAS unsigned* bst = (volatile LAS unsigned*)(ldsl + 131072 + 512);
    if (threadIdx.x < 2) bst[threadIdx.x] = 0u;
    __syncthreads();
    XcdBarrier bar = xcd_barrier_post((unsigned*)(a.ws + WS_BAR), bst);
    if (a.ph_hi < 0) cg::this_grid().sync();
#define GRID_SYNC() xcd_barrier(bar)
    int rep = 0; (void)rep;
    for (int ph = a.ph_lo; ph < a.ph_hi; ++ph) {
        if (ph == 0) { phase_mods(a, (char*)lds, G); __syncthreads(); prep_items(a, (char*)lds, 0, 0, PIT_WA, c * 8 + (opaque_tid() >> 6), G * 8); }
        else if (ph == 1) { phase_rows(a, G, 0, MT, nullptr, nullptr, nullptr, 0, a.in[I_X], a.in[I_CTX], modb, 0, DM, nullptr, true); }
        else {
            const int l = (ph - 2) / 9, k = (ph - 2) % 9; const bool last = (l == 1);
            const float* mod = modb + (size_t)l * 9 * MODW;
            const int nM = last ? 64 : 72;
            if (k == 0) {
                {
                    pg8::SchedG S{(const char*)(a.ws + WS_H), (const char*)(a.ws + WS_WA), DM * 2, nM, 18, 32, G, c, last ? 16 : 0, 64, 4, 8, 0};
                    pg8::EpiP E{(bf16_t*)(a.ws + WS_P)};
                    pg8::gemm_phase(ldsl, DM, S, E); }
                {
                    pg8::SchedG S{(const char*)(a.ws + WS_H8), (const char*)(a.ws + WS_WG8), 4096, nM, 32, 16, G, c, 0, 0, 0, 1, 18};
                    pg8::EpiG E{(bf16_t*)(a.ws + WS_G), a.in[I_BGATE] + (size_t)l * GW};
                    pg8::gemm_phase<pg8::EpiG, pg8::SchedG, true>(ldsl, DM, S, E); }
                if (!last) { const int busy = (nM * 18) % G;
                    if (c >= busy) { prep_items(a, (char*)lds, 0, PIT_WA, PNIT, (c - busy) * 8 + (opaque_tid() >> 6), (G - busy) * 8); prep_poolfold(a, 0, c - busy, G - busy); } }
            } else if (k == 1) phase_local(a, (char*)lds, G, l);
            else if (k == 2) phase_attn(a, (char*)lds, G, l);
            else if (k == 3) {
                pg8::SchedSeg S{(const char*)(a.ws + WS_BR), (const char*)(a.ws + WS_WB), BRK, nM, 8, G, c};
                pg8::EpiB E{(bf16_t*)(a.ws + WS_H), (const bf16_t*)(a.ws + WS_G)};
                pg8::gemm_phase(ldsl, BRK, S, E);
            } else if (k == 4 || k == 7) {
                const bool mix = (k == 4);
                const int ld = mix ? DM : DFF;
                pg8::SchedG S{(const char*)(a.ws + (mix ? WS_H : WS_G)), (const char*)(a.ws + (mix ? WS_WC : WS_WE)), ld * 2, nM, 8, ld / 64, G, c, 0, 0, 0, 1, 0};
                pg8::EpiRaw E{(bf16_t*)(a.ws + WS_P), DM};
                pg8::gemm_phase(ldsl, ld, S, E);
                if (!last) { const int busy = (nM * 8) % G;
                    if (c >= busy) { const int wk = (c - busy) * 8 + (opaque_tid() >> 6), nw = (G - busy) * 8;
                        if (mix) prep_items(a, (char*)lds, 1, 0, PIT_WA, wk, nw);
                        else { prep_items(a, (char*)lds, 1, PIT_WA, PIT_WE, wk, nw); prep_poolfold(a, 1, c - busy, G - busy); } } }
            } else if (k == 5) phase_rows(a, G, 1, nM * 256, a.in[I_LN1G] + l * DM, a.in[I_LN1B] + l * DM, mod, 2 * DM,
                                          l == 0 ? a.in[I_X] : a.out, l == 0 ? a.in[I_CTX] : (const float*)(a.ws + WS_XC), mod, 3 * DM, 4 * DM, a.out, false);
            else if (k == 6) {
                pg8::SchedG S{(const char*)(a.ws + WS_H), (const char*)(a.ws + WS_WD), DM * 2, nM, 44, 32, G, c, 0, 0, 0, 1, 0};
                pg8::EpiSwiglu E{(bf16_t*)(a.ws + WS_G)};
                pg8::gemm_phase(ldsl, DM, S, E);
            } else {
                if (!last) { phase_rows(a, G, 1, MT, a.in[I_LN2G], a.in[I_LN2B], mod, 5 * DM, a.out, (const float*)(a.ws + WS_XC), modb + (size_t)9 * MODW, 0, DM, a.out, true); prep_items(a, (char*)lds, 1, PIT_WE, PNIT, c * 8 + (opaque_tid() >> 6), G * 8); }
                else phase_rows(a, G, 2, ML, a.in[I_LN2G] + DM, a.in[I_LN2B] + DM, mod, 5 * DM, a.out, nullptr, nullptr, 0, 0, a.out, false);
            }
        }
#ifdef PROBE_DUP
        {
            const int kk = ph < 2 ? -1 : (ph - 2) % 9;
            const bool isgemm = kk == 0 || kk == 3 || kk == 4 || kk == 6 || kk == 7, isattn = kk == 2;
            const bool dup = (PROBE_DUP == 1 && isgemm) || (PROBE_DUP == 3 && !isgemm && !isattn) || (PROBE_DUP == 4 && isattn) || (PROBE_DUP == 5 && kk == 1) || (PROBE_DUP == 6 && ph < 2) || (PROBE_DUP == 7 && kk == 0) || (PROBE_DUP == 8 && kk == 3) || (PROBE_DUP == 9 && kk == 6);
            if (PROBE_DUP == 2) GRID_SYNC();
            if (dup && rep == 0) { GRID_SYNC(); rep = 1; --ph; continue; }
            rep = 0;
        }
#endif
        if (ph + 1 < a.ph_hi) GRID_SYNC();
    }
#ifdef DBG_PH
    GRID_SYNC();
    {
        const int gt = blockIdx.x * 512 + threadIdx.x, NT = gridDim.x * 512;
        for (size_t i = gt; i < (size_t)ML * DM; i += NT) { const size_t m = i >> 11; const int cc = (int)(i & 2047);
#if DBG_KIND == 0
            a.out[i] = ((const float*)(a.ws + DBG_SRC))[m * DBG_LD + DBG_COL0 + cc];
#else
            a.out[i] = bf2f(((const bf16_t*)(a.ws + DBG_SRC))[m * DBG_LD + DBG_COL0 + cc]);
#endif
        }
    }
#endif
}

extern "C" void kernel_launch(void* const* d_in, const int* in_sizes, int n_in, void* d_out, int out_size, void* d_ws, size_t ws_size, hipStream_t stream) {
    static int grid = 0;
    if (grid == 0) {
        if (n_in != 30 || in_sizes[0] != ML * DM || out_size != ML * DM || ws_size < WS_END) {
            fprintf(stderr, "kernel_launch: unexpected shapes: n_in %d in0 %d out %d ws %zu (need %zu)\n", n_in, n_in > 0 ? in_sizes[0] : -1, out_size, ws_size, (size_t)WS_END); grid = -1; return; }
        int dev = 0, cus = 0, per_cu = 0;
        hipGetDevice(&dev); hipDeviceGetAttribute(&cus, hipDeviceAttributeMultiprocessorCount, dev);
        if (hipFuncSetAttribute((const void*)mega_fwd, hipFuncAttributeMaxDynamicSharedMemorySize, LDS_BYTES) != hipSuccess) { fprintf(stderr, "kernel_launch: hipFuncSetAttribute failed\n"); grid = -1; return; }
        if (hipOccupancyMaxActiveBlocksPerMultiprocessor(&per_cu, (const void*)mega_fwd, 512, LDS_BYTES) != hipSuccess || per_cu < 1) { fprintf(stderr, "kernel_launch: occupancy query gave %d\n", per_cu); per_cu = 1; }
        (void)hipGetLastError();
        grid = cus * per_cu;
        fprintf(stderr, "kernel_launch: grid %d (cus %d x %d)\n", grid, cus, per_cu);
    }
    if (grid < 0) return;
    Args a{};
    for (int i = 0; i < 30; ++i) a.in[i] = (const float*)d_in[i];
    a.out = (float*)d_out; a.ws = (unsigned char*)d_ws;
#if MK_ONE_LAUNCH
    (void)hipMemsetAsync((char*)d_ws + WS_BAR, 0, 16384, stream);
#ifdef DBG_PH
    a.ph_lo = 0; a.ph_hi = DBG_PH + 1;
#else
    a.ph_lo = 0; a.ph_hi = NPHASE;
#endif
    void* kargs[] = {&a};
    hipError_t e = hipLaunchCooperativeKernel((const void*)mega_fwd, dim3(grid), dim3(512), kargs, LDS_BYTES, stream);
    if (e != hipSuccess) fprintf(stderr, "cooperative launch failed: %s (grid %d)\n", hipGetErrorString(e), grid);
#else
    for (int ph = 0; ph < NPHASE; ++ph) {
        a.ph_lo = ph; a.ph_hi = ph + 1;
        hipLaunchKernelGGL(mega_fwd, dim3(grid), dim3(512), LDS_BYTES, stream, a);
    }
#endif
}
```

```cpp
#include <hip/hip_runtime.h>
#include <hip/hip_bf16.h>
#include <hip/hip_cooperative_groups.h>
#include <cstdio>
#include <cstdint>
namespace cg = cooperative_groups;

#ifndef MK_ONE_LAUNCH
#define MK_ONE_LAUNCH 1
#endif

#define LAS __attribute__((address_space(3)))
typedef unsigned short bf16_t;
typedef short bf16x8 __attribute__((ext_vector_type(8)));
typedef short s16x4 __attribute__((ext_vector_type(4)));
typedef float f32x4 __attribute__((ext_vector_type(4)));
typedef float f32x16 __attribute__((ext_vector_type(16)));
typedef unsigned u32x4 __attribute__((ext_vector_type(4)));
typedef unsigned u32x2 __attribute__((ext_vector_type(2)));
typedef int i32x4 __attribute__((ext_vector_type(4)));
typedef int i32x8 __attribute__((ext_vector_type(8)));

constexpr int DM = 2048, NBATCH = 8, SEQ = 2048, CTXL = 256;
constexpr int ML = NBATCH * SEQ, MC = NBATCH * CTXL, MT = ML + MC;
constexpr int INW = 4608, GW = 8192, NA = INW + GW, BRK = 2560, DFF = 5632, NDU = 2 * DFF;
constexpr int KVLEN = CTXL + SEQ;
constexpr int MODW = 6 * DM;
constexpr float ALPHA = 1.4142135623730951f;
constexpr float LN_EPS = 1e-5f, RMS_EPS = 1e-6f;

constexpr size_t MiB = 1u << 20;
constexpr size_t WS_ROPE = 0;
constexpr size_t WS_BAR = 65536;
constexpr size_t WS_MOD = 1 * MiB;
constexpr size_t WS_WA = 2 * MiB;
constexpr size_t WS_WB = WS_WA + 50 * MiB;
constexpr size_t WS_WC = WS_WB + 10 * MiB;
constexpr size_t WS_WD = WS_WC + 8 * MiB;
constexpr size_t WS_WE = WS_WD + 44 * MiB;
constexpr size_t WS_XC = WS_WE + 22 * MiB;
constexpr size_t WS_H = WS_XC + 16 * MiB;
constexpr size_t WS_P = WS_H + 72 * MiB;
constexpr size_t WS_G = WS_P + 162 * MiB;
constexpr size_t WS_BR = WS_G + 288 * MiB;
constexpr size_t WS_QB = WS_BR + 90 * MiB;
constexpr size_t WS_KB = WS_QB + 36 * MiB;
constexpr size_t WS_VB = WS_KB + 9 * MiB;
constexpr size_t WS_END = WS_VB + 9 * MiB;
constexpr size_t WS_H8 = WS_BR;
constexpr size_t WS_WG8 = WS_WA + 18 * MiB;
constexpr float WG8_SCALE = 64.f;

constexpr int LDS_BYTES = 147456;

typedef float f32x2_t __attribute__((ext_vector_type(2)));
typedef __bf16 bf16x2_t __attribute__((ext_vector_type(2)));
__device__ __forceinline__ unsigned cvt_pk_bf16(float lo, float hi) { f32x2_t v = {lo, hi}; bf16x2_t r = __builtin_convertvector(v, bf16x2_t); return __builtin_bit_cast(unsigned, r); }
__device__ __forceinline__ float bflo(unsigned w) { return __uint_as_float(w << 16); }
__device__ __forceinline__ float bfhi(unsigned w) { return __uint_as_float(w & 0xffff0000u); }
__device__ __forceinline__ float bf2f(bf16_t h) { return __uint_as_float((unsigned)h << 16); }
__device__ __forceinline__ bf16_t f2bf(float f) { return (bf16_t)(cvt_pk_bf16(f, 0.f) & 0xffffu); }
__device__ __forceinline__ float sigmoidf_(float x) { return __builtin_amdgcn_rcpf(1.f + __builtin_amdgcn_exp2f(-1.4426950408889634f * x)); }
__device__ __forceinline__ float gelu_tanh(float x) { const float z = 1.5957691216057308f * (x + 0.044715f * x * x * x); return x * sigmoidf_(z); }
__device__ __forceinline__ float wave_sum(float v) {
#pragma unroll
    for (int o = 1; o < 64; o <<= 1) v += __shfl_xor(v, o);
    return v;
}
#define LDS_WAIT() asm volatile("s_waitcnt lgkmcnt(0)" ::: "memory")
__device__ __forceinline__ int opaque_tid() { int t = threadIdx.x; asm volatile("" : "+v"(t)); return t; }

namespace pg8 {
constexpr int BM = 256, BK = 64, HALF = 128, HTB = HALF * BK * 2, STAGE_BYTES = 8 * HTB;
__host__ __device__ __forceinline__ int lds_byte(int r, int c) { const int st = (r >> 4) * 2 + (c >> 5), rr = r & 15, cc = c & 31, ob = rr * 64 + cc * 2; return st * 1024 + (ob ^ (((ob >> 9) & 1) << 5)); }
__host__ __device__ __forceinline__ void stage_rc(int b, int& R, int& C) { const int st = b / 1024, sb = b % 1024, swz = sb ^ (((sb >> 9) & 1) << 5); R = (st >> 1) * 16 + swz / 64; C = (st & 1) * 32 + (swz % 64) / 2; }
__host__ __device__ __forceinline__ int perm32(int rho) { const int n = rho >> 4, i = rho & 15; return 8 * (i >> 2) + 4 * n + (i & 3); }

struct Unit { int pm, pn, seg, nt, f8; const char* a; const char* b; };

__device__ __forceinline__ void tile_of(int L, int nM, int nN, int& pm, int& pn) {
    const int nwg = nM * nN; int wgid = L;
    { const int q = nwg / 8, r = nwg % 8, xcd = wgid % 8, off = wgid / 8; wgid = (xcd < r ? xcd * (q + 1) : r * (q + 1) + (xcd - r) * q) + off; }
    const int nig = 8 * nN, gid = wgid / nig, fm = gid * 8, gsz = (nM - fm) < 8 ? (nM - fm) : 8;
    pm = fm + ((wgid % nig) % gsz); pn = (wgid % nig) / gsz;
}

template <class Epi, class Sched, bool F8 = false>
__device__ __forceinline__ void gemm_phase(LAS unsigned char* lds, const int ld, const Sched& S, const Epi& E) {
    const int tid = opaque_tid(), wid = __builtin_amdgcn_readfirstlane(tid >> 6), lane = tid & 63, wr = wid >> 2, wc = wid & 3, fr = lane & 15, fq = lane >> 4;
    unsigned voffA[2], voffB[2];
#pragma unroll
    for (int i = 0; i < 2; ++i) { int R, C; stage_rc(tid * 16 + i * 8192, R, C); const int Rb = Epi::PERM ? ((R & ~31) + perm32(R & 31)) : R;
        voffA[i] = (unsigned)(R * ld + C) * 2u; voffB[i] = (unsigned)(Rb * ld + C) * 2u; }
    const size_t kstep = (size_t)(BK * 2);
    const size_t hstep = (size_t)HALF * ld * 2;
    const unsigned ldsw = (unsigned)wid * 1024u;
    const int aoff = lds_byte(wr * 64 + fr, fq * 8), boff = lds_byte(wc * 32 + fr, fq * 8);
#define PG8_SA(b, h) (((b) * 2 + (h)) * HTB)
#define PG8_SB(b, h) ((4 + (b) * 2 + (h)) * HTB)
#define PG8_STAGE(bufoff, gbase, voff) do { _Pragma("unroll") for (int _i = 0; _i < 2; ++_i) \
        __builtin_amdgcn_global_load_lds((const unsigned*)((const char*)(gbase) + (voff)[_i]), (LAS unsigned*)(lds + (bufoff) + ldsw + _i * 8192), 16, 0, 0); } while (0)
#define PG8_LD8(p) __builtin_shufflevector(*(const LAS i32x4*)(p), *(const LAS i32x4*)((p) + 1024), 0, 1, 2, 3, 4, 5, 6, 7)
#define PG8_LDA(dst, b, h) do { _Pragma("unroll") for (int m = 0; m < 4; ++m) dst[m] = PG8_LD8(lds + PG8_SA(b, h) + aoff + m * 2048); } while (0)
#define PG8_LDB(dst, b, h) do { _Pragma("unroll") for (int n = 0; n < 2; ++n) dst[n] = PG8_LD8(lds + PG8_SB(b, h) + boff + n * 2048); } while (0)
#define PG8_LO(x) __builtin_bit_cast(bf16x8, __builtin_shufflevector(x, x, 0, 1, 2, 3))
#define PG8_HI(x) __builtin_bit_cast(bf16x8, __builtin_shufflevector(x, x, 4, 5, 6, 7))
#define PG8_MMA16(ai, bj, At, Bt) do { __builtin_amdgcn_s_setprio(1); _Pragma("unroll") for (int m = 0; m < 4; ++m) _Pragma("unroll") for (int n = 0; n < 2; ++n) { \
        acc[ai][bj][m][n] = __builtin_amdgcn_mfma_f32_16x16x32_bf16(PG8_LO(Bt[n]), PG8_LO(At[m]), acc[ai][bj][m][n], 0, 0, 0); \
        acc[ai][bj][m][n] = __builtin_amdgcn_mfma_f32_16x16x32_bf16(PG8_HI(Bt[n]), PG8_HI(At[m]), acc[ai][bj][m][n], 0, 0, 0); } __builtin_amdgcn_s_setprio(0); } while (0)
#define PG8_MMA8(ai, bj, At, Bt) do { __builtin_amdgcn_s_setprio(1); _Pragma("unroll") for (int m = 0; m < 4; ++m) _Pragma("unroll") for (int n = 0; n < 2; ++n) \
        asm volatile("v_mfma_scale_f32_16x16x128_f8f6f4 %0, %1, %2, %0, %3, %3 op_sel_hi:[0,0,0]" : "+v"(acc[ai][bj][m][n]) : "v"(Bt[n]), "v"(At[m]), "v"(sc1)); \
        __builtin_amdgcn_s_setprio(0); } while (0)
#define PG8_WAIT_V(n) asm volatile("s_waitcnt vmcnt(" #n ")" ::: "memory")
#define PG8_WAIT_L(n) asm volatile("s_waitcnt lgkmcnt(" #n ")" ::: "memory")
#define PG8_BAR __builtin_amdgcn_s_barrier()
#define PG8_SCHED __builtin_amdgcn_sched_barrier(0)
#define PG8_KLOOP(MMA) for (int t = 0; t < nt; t += 2) { \
            const bool last = (t == nt - 2); \
            const char* a1 = cA + (size_t)(t + 1) * kstep; \
            const char* a2 = last ? nA : cA + (size_t)(t + 2) * kstep; const char* b2 = last ? nB : cB + (size_t)(t + 2) * kstep; \
            const char* a3 = a2 + kstep; const char* b3 = b2 + kstep; \
            PG8_LDB(B0, 0, 0); PG8_LDB(B1, 0, 1); PG8_SCHED; PG8_LDA(At, 0, 0); PG8_STAGE(PG8_SA(1, 1), a1 + hstep, voffA); \
            PG8_WAIT_V(8); PG8_WAIT_L(0); PG8_BAR; MMA(0, 0, At, B0); MMA(0, 1, At, B1); PG8_BAR; PG8_SCHED; \
            PG8_LDA(At, 0, 1); PG8_STAGE(PG8_SB(0, 0), b2, voffB); PG8_STAGE(PG8_SB(0, 1), b2 + hstep, voffB); PG8_STAGE(PG8_SA(0, 0), a2, voffA); \
            PG8_WAIT_V(8); PG8_WAIT_L(0); PG8_BAR; MMA(1, 0, At, B0); MMA(1, 1, At, B1); PG8_BAR; PG8_SCHED; \
            PG8_LDB(B0, 1, 0); PG8_LDB(B1, 1, 1); PG8_SCHED; PG8_LDA(At, 1, 0); PG8_STAGE(PG8_SA(0, 1), a2 + hstep, voffA); \
            PG8_WAIT_V(8); PG8_WAIT_L(0); PG8_BAR; MMA(0, 0, At, B0); MMA(0, 1, At, B1); PG8_BAR; PG8_SCHED; \
            PG8_LDA(At, 1, 1); PG8_STAGE(PG8_SB(1, 0), b3, voffB); PG8_STAGE(PG8_SB(1, 1), b3 + hstep, voffB); PG8_STAGE(PG8_SA(1, 0), a3, voffA); \
            PG8_WAIT_V(8); PG8_WAIT_L(0); PG8_BAR; MMA(1, 0, At, B0); MMA(1, 1, At, B1); PG8_BAR; PG8_SCHED; }
    Unit cur, nxt; int ui = 0;
    if (!S.next(0, cur)) return;
    f32x4 acc[2][2][4][2];
#pragma unroll
    for (int a = 0; a < 2; ++a)
#pragma unroll
        for (int b = 0; b < 2; ++b)
#pragma unroll
            for (int m = 0; m < 4; ++m)
#pragma unroll
                for (int n = 0; n < 2; ++n) acc[a][b][m][n] = (f32x4){0.f, 0.f, 0.f, 0.f};
    i32x8 At[4], B0[2], B1[2];
    const int sc1 = 0x7f7f7f7f;
    const char* cA = cur.a; const char* cB = cur.b;
    {
        PG8_STAGE(PG8_SB(0, 0), cB, voffB); PG8_STAGE(PG8_SB(0, 1), cB + hstep, voffB); PG8_STAGE(PG8_SA(0, 0), cA, voffA); PG8_STAGE(PG8_SA(0, 1), cA + hstep, voffA);
        if (wr == 1) PG8_BAR;
        PG8_WAIT_V(2); PG8_BAR;
        PG8_STAGE(PG8_SB(1, 0), cB + kstep, voffB); PG8_STAGE(PG8_SA(1, 0), cA + kstep, voffA); PG8_STAGE(PG8_SB(1, 1), cB + hstep + kstep, voffB);
        PG8_WAIT_V(6); PG8_BAR;
    }
    for (;;) {
        const bool has_next = S.next(ui + 1, nxt);
        const char* nA = has_next ? nxt.a : cA; const char* nB = has_next ? nxt.b : cB;
        const int nt = cur.nt;
        if constexpr (F8) { PG8_KLOOP(PG8_MMA8) asm volatile("s_nop 15\n\ts_nop 15" ::: "memory"); } else { PG8_KLOOP(PG8_MMA16) }
        if (wr == 0) PG8_BAR;
        E(acc, cur, wr, wc, fr, fq);
        if (!has_next) break;
        if (!(Epi::CARRY && cur.seg < 3)) {
#pragma unroll
            for (int a = 0; a < 2; ++a)
#pragma unroll
                for (int b = 0; b < 2; ++b)
#pragma unroll
                    for (int m = 0; m < 4; ++m)
#pragma unroll
                        for (int n = 0; n < 2; ++n) acc[a][b][m][n] = (f32x4){0.f, 0.f, 0.f, 0.f}; }
        cur = nxt; cA = nA; cB = nB; ++ui;
        if (wr == 1) PG8_BAR;
    }
    PG8_WAIT_V(0);
    PG8_BAR;
#undef PG8_SA
#undef PG8_SB
#undef PG8_STAGE
#undef PG8_LDA
#undef PG8_LDB
#undef PG8_MMA16
#undef PG8_MMA8
#undef PG8_LD8
#undef PG8_LO
#undef PG8_HI
#undef PG8_KLOOP
#undef PG8_WAIT_V
#undef PG8_WAIT_L
#undef PG8_BAR
#undef PG8_SCHED
}

struct SchedG {
    const char* A; const char* B; int rowB, nM, nN, nt, G, c, nExtra, exPm0, exPn0, exNm, pn0;
    __device__ __forceinline__ bool next(int i, Unit& u) const {
        const int L = i * G + c, nwg = nM * nN;
        if (L < nwg) tile_of(L, nM, nN, u.pm, u.pn);
        else if (L < nwg + nExtra) { const int idx = L - nwg; u.pm = exPm0 + idx % exNm; u.pn = exPn0 + idx / exNm; }
        else return false;
        u.seg = 0; u.f8 = 0; u.nt = nt; u.a = A + (size_t)u.pm * 256 * rowB; u.b = B + (size_t)u.pn * 256 * rowB; u.pn += pn0; return true;
    }
};
struct SchedSeg {
    const char* A; const char* B; int ld, nM, nN, G, c;
    __device__ __forceinline__ bool next(int i, Unit& u) const {
        const int L = (i >> 2) * G + c; if (L >= nM * nN) return false;
        tile_of(L, nM, nN, u.pm, u.pn);
        const int s = i & 3; u.seg = s; u.f8 = 0; u.nt = s == 0 ? 16 : 8; const int koff = s == 0 ? 0 : 512 + 512 * s;
        u.a = A + ((size_t)u.pm * 256 * ld + koff) * 2; u.b = B + ((size_t)u.pn * 256 * ld + koff) * 2; return true;
    }
};

struct EpiP {
    static constexpr bool PERM = true, CARRY = false;
    bf16_t* P;
    __device__ __forceinline__ void operator()(const f32x4 (&acc)[2][2][4][2], const Unit& u, int wr, int wc, int fr, int fq) const {
        const int row0 = u.pm * 256 + wr * 64 + fr; const int colt = u.pn * 256 + wc * 32 + 8 * fq;
#pragma unroll
        for (int ai = 0; ai < 2; ++ai)
#pragma unroll
            for (int m = 0; m < 4; ++m) { bf16_t* rowp = P + (size_t)(row0 + ai * 128 + m * 16) * INW + colt;
#pragma unroll
                for (int bj = 0; bj < 2; ++bj) { const f32x4 v0 = acc[ai][bj][m][0], v1 = acc[ai][bj][m][1];
                    u32x4 w; w.x = cvt_pk_bf16(v0[0], v0[1]); w.y = cvt_pk_bf16(v0[2], v0[3]); w.z = cvt_pk_bf16(v1[0], v1[1]); w.w = cvt_pk_bf16(v1[2], v1[3]);
                    *(u32x4*)(rowp + bj * 128) = w; } }
    }
};
struct EpiG {
    static constexpr bool PERM = true, CARRY = false;
    bf16_t* Gt; const float* bg;
    __device__ __forceinline__ void operator()(const f32x4 (&acc)[2][2][4][2], const Unit& u, int wr, int wc, int fr, int fq) const {
        const int t512 = (wr * 4 + wc) * 64 + fq * 16 + fr;
        const int gc = (u.pn - 18) * 256 + wc * 32 + 8 * fq;
        f32x4 bv[2][2];
#pragma unroll
        for (int bj = 0; bj < 2; ++bj)
#pragma unroll
            for (int n = 0; n < 2; ++n) bv[bj][n] = *(const f32x4*)(bg + gc + bj * 128 + 4 * n);
        u32x4* gdst = (u32x4*)Gt + (size_t)(u.pm * 32 + (u.pn - 18)) * 8192 + t512;
        constexpr float SC = 1.f / WG8_SCALE;
#pragma unroll
        for (int ai = 0; ai < 2; ++ai)
#pragma unroll
            for (int m = 0; m < 4; ++m) {
#pragma unroll
                for (int bj = 0; bj < 2; ++bj) { const f32x4 v0 = acc[ai][bj][m][0] * SC + bv[bj][0], v1 = acc[ai][bj][m][1] * SC + bv[bj][1];
                    u32x4 w; w.x = cvt_pk_bf16(v0[0], v0[1]); w.y = cvt_pk_bf16(v0[2], v0[3]); w.z = cvt_pk_bf16(v1[0], v1[1]); w.w = cvt_pk_bf16(v1[2], v1[3]);
                    __builtin_nontemporal_store(w, &gdst[((ai * 4 + m) * 2 + bj) * 512]); } }
    }
};
struct EpiB {
    static constexpr bool PERM = true, CARRY = true;
    bf16_t* MG; const bf16_t* Gt;
    __device__ __forceinline__ void operator()(f32x4 (&acc)[2][2][4][2], const Unit& u, int wr, int wc, int fr, int fq) const {
        const int row0 = u.pm * 256 + wr * 64 + fr; const int colt = u.pn * 256 + wc * 32 + 8 * fq; const int seg = u.seg;
        const int t512 = (wr * 4 + wc) * 64 + fq * 16 + fr;
        const u32x4* gsrc = (const u32x4*)Gt + (size_t)(u.pm * 32 + seg * 8 + u.pn) * 8192 + t512;
        const u32x4* gnxt = gsrc + (size_t)8 * 8192;
#pragma unroll
        for (int ai = 0; ai < 2; ++ai) {
            u32x4 gw[8], gn[8];
#pragma unroll
            for (int j = 0; j < 8; ++j) gw[j] = __builtin_nontemporal_load(&gsrc[(ai * 8 + j) * 512]);
            if (seg < 3) {
#pragma unroll
                for (int j = 0; j < 8; ++j) gn[j] = gnxt[(ai * 8 + j) * 512]; }
#pragma unroll
            for (int m = 0; m < 4; ++m) { const size_t row = (size_t)(row0 + ai * 128 + m * 16);
#pragma unroll
                for (int bj = 0; bj < 2; ++bj) { const int j = m * 2 + bj;
                    const f32x4 a0 = acc[ai][bj][m][0], a1 = acc[ai][bj][m][1];
                    float v0 = a0[0] * sigmoidf_(bflo(gw[j].x)), v1 = a0[1] * sigmoidf_(bfhi(gw[j].x)), v2 = a0[2] * sigmoidf_(bflo(gw[j].y)), v3 = a0[3] * sigmoidf_(bfhi(gw[j].y));
                    float v4 = a1[0] * sigmoidf_(bflo(gw[j].z)), v5 = a1[1] * sigmoidf_(bfhi(gw[j].z)), v6 = a1[2] * sigmoidf_(bflo(gw[j].w)), v7 = a1[3] * sigmoidf_(bfhi(gw[j].w));
                    if (seg < 3) {
#define INVG(x) (1.f + __builtin_amdgcn_exp2f(-1.4426950408889634f * (x)))
                        acc[ai][bj][m][0] = (f32x4){v0 * INVG(bflo(gn[j].x)), v1 * INVG(bfhi(gn[j].x)), v2 * INVG(bflo(gn[j].y)), v3 * INVG(bfhi(gn[j].y))};
                        acc[ai][bj][m][1] = (f32x4){v4 * INVG(bflo(gn[j].z)), v5 * INVG(bfhi(gn[j].z)), v6 * INVG(bflo(gn[j].w)), v7 * INVG(bfhi(gn[j].w))};
#undef INVG
                    } else {
                        u32x4 w; w.x = cvt_pk_bf16(v0, v1); w.y = cvt_pk_bf16(v2, v3); w.z = cvt_pk_bf16(v4, v5); w.w = cvt_pk_bf16(v6, v7);
                        *(u32x4*)(MG + row * DM + colt + bj * 128) = w; } } }
        }
    }
};
struct EpiRaw {
    static constexpr bool PERM = true, CARRY = false;
    bf16_t* O; int ldc;
    __device__ __forceinline__ void operator()(const f32x4 (&acc)[2][2][4][2], const Unit& u, int wr, int wc, int fr, int fq) const {
        const int row0 = u.pm * 256 + wr * 64 + fr; const int colt = u.pn * 256 + wc * 32 + 8 * fq;
#pragma unroll
        for (int ai = 0; ai < 2; ++ai)
#pragma unroll
            for (int m = 0; m < 4; ++m) { bf16_t* rowp = O + (size_t)(row0 + ai * 128 + m * 16) * ldc + colt;
#pragma unroll
                for (int bj = 0; bj < 2; ++bj) { const f32x4 v0 = acc[ai][bj][m][0], v1 = acc[ai][bj][m][1];
                    u32x4 w; w.x = cvt_pk_bf16(v0[0], v0[1]); w.y = cvt_pk_bf16(v0[2], v0[3]); w.z = cvt_pk_bf16(v1[0], v1[1]); w.w = cvt_pk_bf16(v1[2], v1[3]);
                    __builtin_nontemporal_store(w, (u32x4*)(rowp + bj * 128)); } }
    }
};
struct EpiSwiglu {
    static constexpr bool PERM = true, CARRY = false;
    bf16_t* ACT;
    __device__ __forceinline__ void operator()(const f32x4 (&acc)[2][2][4][2], const Unit& u, int wr, int wc, int fr, int fq) const {
        const int row0 = u.pm * 256 + wr * 64 + fr; const int colt = u.pn * 128 + wc * 32 + 8 * fq;
#pragma unroll
        for (int ai = 0; ai < 2; ++ai)
#pragma unroll
            for (int m = 0; m < 4; ++m) { const f32x4 g0 = acc[ai][0][m][0], g1 = acc[ai][0][m][1], u0 = acc[ai][1][m][0], u1 = acc[ai][1][m][1];
                u32x4 w;
                w.x = cvt_pk_bf16(g0[0] * sigmoidf_(g0[0]) * u0[0], g0[1] * sigmoidf_(g0[1]) * u0[1]);
                w.y = cvt_pk_bf16(g0[2] * sigmoidf_(g0[2]) * u0[2], g0[3] * sigmoidf_(g0[3]) * u0[3]);
                w.z = cvt_pk_bf16(g1[0] * sigmoidf_(g1[0]) * u1[0], g1[1] * sigmoidf_(g1[1]) * u1[1]);
                w.w = cvt_pk_bf16(g1[2] * sigmoidf_(g1[2]) * u1[2], g1[3] * sigmoidf_(g1[3]) * u1[3]);
                *(u32x4*)(ACT + (size_t)(row0 + ai * 128 + m * 16) * DFF + colt) = w; }
    }
};
}

namespace att {
constexpr int D = 128, NW = 8, QBLK = 32, KVBLK = 64;
constexpr float SCALE = 0.088388347648318440f;
constexpr float THR = 8.f;
constexpr int LDQ = 1024, LDK = 256, LDO = BRK;
constexpr size_t SHM_V = KVBLK * D * 2, SHM_K = KVBLK * D * 2, SHM_ATTN = 2 * SHM_V + 2 * SHM_K + NW * 64 * 4;
#define KSWZ(row, colB) ((row) * 256 + ((colB) ^ (((row) & 7) << 4)))
#define SBAR() __builtin_amdgcn_sched_barrier(0)
__device__ __forceinline__ int crow(int r, int hi) { return (r & 3) + 8 * (r >> 2) + 4 * hi; }
__device__ __forceinline__ void partialSM(f32x16& p0, f32x16& p1, float& m_reg, float& mn, float& alpha) {
  constexpr float C = SCALE * 1.4426950408889634f;
  float pmax = p0[0]; for (int r = 1; r < 16; ++r) pmax = fmaxf(pmax, p0[r]); for (int r = 0; r < 16; ++r) pmax = fmaxf(pmax, p1[r]);
  { auto rr = __builtin_amdgcn_permlane32_swap(__float_as_uint(pmax), __float_as_uint(pmax), false, false);
    pmax = fmaxf(__uint_as_float(rr[0]), __uint_as_float(rr[1])); }
  if (__builtin_expect(__all(pmax - m_reg <= THR / SCALE), 1)) { mn = m_reg; alpha = 1.f; }
  else { mn = fmaxf(m_reg, pmax); alpha = __builtin_amdgcn_exp2f((m_reg - mn) * C); m_reg = mn; }
  float mnC = -mn * C;
  for (int r = 0; r < 16; ++r) p0[r] = fmaf(p0[r], C, mnC); for (int r = 0; r < 16; ++r) p1[r] = fmaf(p1[r], C, mnC);
  for (int r = 0; r < 16; ++r) p0[r] = __builtin_amdgcn_exp2f(p0[r]);
}
__device__ __forceinline__ void finishSM(f32x16& p0, f32x16& p1, float alpha, float& l_reg, bf16x8& pa0, bf16x8& pa1, bf16x8& pa2, bf16x8& pa3) {
  for (int r = 0; r < 16; ++r) p1[r] = __builtin_amdgcn_exp2f(p1[r]);
  float ps = 0; for (int r = 0; r < 16; ++r) ps += p0[r]; for (int r = 0; r < 16; ++r) ps += p1[r];
  { auto rr = __builtin_amdgcn_permlane32_swap(__float_as_uint(ps), __float_as_uint(ps), false, false);
    ps = __uint_as_float(rr[0]) + __uint_as_float(rr[1]); }
  l_reg = l_reg * alpha + ps;
#define PK4(P, BASE, OUT) do { unsigned a0 = cvt_pk_bf16(P[BASE + 0], P[BASE + 1]), a1 = cvt_pk_bf16(P[BASE + 2], P[BASE + 3]);   \
    unsigned b0 = cvt_pk_bf16(P[BASE + 4], P[BASE + 5]), b1 = cvt_pk_bf16(P[BASE + 6], P[BASE + 7]);                              \
    auto r0 = __builtin_amdgcn_permlane32_swap(a0, b0, false, false); auto r1 = __builtin_amdgcn_permlane32_swap(a1, b1, false, false); \
    u32x4 w = {r0[0], r1[0], r0[1], r1[1]}; OUT = *reinterpret_cast<bf16x8*>(&w); } while (0)
  PK4(p0, 0, pa0); PK4(p0, 8, pa1); PK4(p1, 0, pa2); PK4(p1, 8, pa3);
#undef PK4
}
__device__ __forceinline__ void qkt(f32x16& p0, f32x16& p1, const bf16_t* Ks, const bf16x8* qr, int r32, int hi) {
  p0 = f32x16{}; p1 = f32x16{};
  for (int d0 = 0; d0 < 8; ++d0) { int cb = (d0 * 16 + hi * 8) * 2;
    bf16x8 b0 = *reinterpret_cast<const bf16x8*>((const char*)Ks + KSWZ(r32, cb));
    bf16x8 b1 = *reinterpret_cast<const bf16x8*>((const char*)Ks + KSWZ(32 + r32, cb));
    p0 = __builtin_amdgcn_mfma_f32_32x32x16_bf16(b0, qr[d0], p0, 0, 0, 0);
    p1 = __builtin_amdgcn_mfma_f32_32x32x16_bf16(b1, qr[d0], p1, 0, 0, 0); }
}
__device__ __forceinline__ int v_st(int k, int c) { const int kk = (k & ~0xC) | ((k & 4) << 1) | ((k & 8) >> 1); return ((kk >> 3) * 4 + (c >> 5)) * 512 + ((kk & 7) * 32 + (c & 31)) * 2; }
__device__ __forceinline__ int v_rd_base(int lane) { return ((lane & 3) << 3) | (((lane >> 2) & 3) << 6) | (((lane >> 4) & 1) << 5) | (((lane >> 5) & 1) << 8); }
constexpr int v_rd_off(int d0, int ks, int half) { return d0 * 512 + ks * 4096 + half * 2048; }
template <int OFF> __device__ __forceinline__ s16x4 tr_read(int vb) {
  s16x4 r; asm volatile("ds_read_b64_tr_b16 %0, %1 offset:%2" : "=&v"(r) : "v"(vb), "i"(OFF) : "memory"); return r;
}
template <int D0> __device__ __forceinline__ void pv_one(f32x16& od, int vb, bf16x8 pa0, bf16x8 pa1, bf16x8 pa2, bf16x8 pa3) {
  const s16x4 l0 = tr_read<v_rd_off(D0, 0, 0)>(vb), h0 = tr_read<v_rd_off(D0, 0, 1)>(vb), l1 = tr_read<v_rd_off(D0, 1, 0)>(vb), h1 = tr_read<v_rd_off(D0, 1, 1)>(vb);
  const s16x4 l2 = tr_read<v_rd_off(D0, 2, 0)>(vb), h2 = tr_read<v_rd_off(D0, 2, 1)>(vb), l3 = tr_read<v_rd_off(D0, 3, 0)>(vb), h3 = tr_read<v_rd_off(D0, 3, 1)>(vb);
  asm volatile("s_waitcnt lgkmcnt(0)" ::: "memory"); SBAR();
#define PK(L, H) (bf16x8){L[0], L[1], L[2], L[3], H[0], H[1], H[2], H[3]}
  od = __builtin_amdgcn_mfma_f32_32x32x16_bf16(pa0, PK(l0, h0), od, 0, 0, 0);
  od = __builtin_amdgcn_mfma_f32_32x32x16_bf16(pa1, PK(l1, h1), od, 0, 0, 0);
  od = __builtin_amdgcn_mfma_f32_32x32x16_bf16(pa2, PK(l2, h2), od, 0, 0, 0);
  od = __builtin_amdgcn_mfma_f32_32x32x16_bf16(pa3, PK(l3, h3), od, 0, 0, 0);
#undef PK
}
__device__ __forceinline__ void pv_d0(f32x16* o, int vb, bf16x8 pa0, bf16x8 pa1, bf16x8 pa2, bf16x8 pa3) {
  pv_one<0>(o[0], vb, pa0, pa1, pa2, pa3); pv_one<1>(o[1], vb, pa0, pa1, pa2, pa3); pv_one<2>(o[2], vb, pa0, pa1, pa2, pa3); pv_one<3>(o[3], vb, pa0, pa1, pa2, pa3);
}
__device__ __forceinline__ void attn_dense_body(const bf16_t* __restrict__ Qb, const bf16_t* __restrict__ Kh, const bf16_t* __restrict__ Vh,
                                                bf16_t* __restrict__ Ob, int seq, char* lds) {
  constexpr int SDEPTH = 2;
  const int tid = opaque_tid(), wid = tid >> 6, lane = tid & 63, r32 = lane & 31, hi = lane >> 5;
  bf16_t* V_lds = (bf16_t*)lds; bf16_t* K_lds = (bf16_t*)(lds + 2 * SHM_V);
  float* ws = (float*)(lds + 2 * SHM_V + 2 * SHM_K) + wid * 64; float* li_l = ws; float* al_l = ws + 32;
  float m_reg = -1e30f, l_reg = 0; f32x16 o[4] = {}; bf16x8 qr[8];
  const bf16_t* Qw = Qb + (long)(wid * QBLK + r32) * LDQ + hi * 8;
#pragma unroll
  for (int d0 = 0; d0 < 8; ++d0) qr[d0] = *reinterpret_cast<const bf16x8*>(Qw + d0 * 16);
  const int sr = tid >> 4, sc = (tid & 15) * 8, vst0 = v_st(sr, sc), vst1 = v_st(32 + sr, sc);
  const int vb0 = (int)(uintptr_t)V_lds + v_rd_base(lane);
  struct { bf16x8 vs0, vs1, ks0, ks1; } sr_[SDEPTH];
#define SLOAD(i, k0) do { sr_[i].vs0 = *reinterpret_cast<const bf16x8*>(&Vh[(long)((k0) + sr) * LDK + sc]); sr_[i].vs1 = *reinterpret_cast<const bf16x8*>(&Vh[(long)((k0) + 32 + sr) * LDK + sc]); \
    sr_[i].ks0 = *reinterpret_cast<const bf16x8*>(&Kh[(long)((k0) + sr) * LDK + sc]); sr_[i].ks1 = *reinterpret_cast<const bf16x8*>(&Kh[(long)((k0) + 32 + sr) * LDK + sc]); } while (0)
#define SWRITE(b, i) do { *(bf16x8*)((char*)V_lds + (b) * SHM_V + vst0) = sr_[i].vs0;          \
    *(bf16x8*)((char*)V_lds + (b) * SHM_V + vst1) = sr_[i].vs1; int kc = sc * 2;               \
    *(bf16x8*)((char*)K_lds + (b) * SHM_K + KSWZ(sr, kc)) = sr_[i].ks0;                       \
    *(bf16x8*)((char*)K_lds + (b) * SHM_K + KSWZ(32 + sr, kc)) = sr_[i].ks1; } while (0)
#define SWAIT() do { asm volatile("s_waitcnt vmcnt(4)" ::: "memory"); } while (0)
#define RESC(a) do { if (__any((a) < 1.f)) { if (hi == 0) al_l[r32] = (a); asm volatile("s_waitcnt lgkmcnt(0)" ::: "memory"); \
    for (int d = 0; d < 4; ++d) for (int r = 0; r < 16; ++r) o[d][r] *= al_l[crow(r, hi)]; } } while (0)
  f32x16 pA0, pA1, pB0, pB1; float mnA, mnB, alA, alB; bf16x8 pa0, pa1, pa2, pa3; const int NT = seq / KVBLK;
  constexpr int SE = 0, SO = SDEPTH - 1;
  SLOAD(SE, 0); asm volatile("s_waitcnt vmcnt(0)" ::: "memory"); SWRITE(0, SE); __syncthreads();
  qkt(pA0, pA1, K_lds, qr, r32, hi); partialSM(pA0, pA1, m_reg, mnA, alA);
  SLOAD(SO, KVBLK); if (2 < NT) SLOAD(SE, 2 * KVBLK);
  SWAIT(); SWRITE(1, SO); __syncthreads();
  for (int j = 1; j + 1 < NT; j += 2) {
    SBAR(); qkt(pB0, pB1, (bf16_t*)((char*)K_lds + SHM_K), qr, r32, hi);
    finishSM(pA0, pA1, alA, l_reg, pa0, pa1, pa2, pa3); SBAR();
    SLOAD(SO, (j + SDEPTH) * KVBLK); SBAR();
    pv_d0(o, vb0, pa0, pa1, pa2, pa3); partialSM(pB0, pB1, m_reg, mnB, alB);
    __syncthreads(); SWAIT(); SWRITE(0, SE);
    RESC(alB); __syncthreads();
    SBAR(); qkt(pA0, pA1, K_lds, qr, r32, hi);
    finishSM(pB0, pB1, alB, l_reg, pa0, pa1, pa2, pa3); SBAR();
    if (j + 3 < NT) SLOAD(SE, (j + 1 + SDEPTH) * KVBLK); SBAR();
    pv_d0(o, vb0 + (int)SHM_V, pa0, pa1, pa2, pa3); partialSM(pA0, pA1, m_reg, mnA, alA);
    __syncthreads(); SWAIT(); SWRITE(1, SO);
    RESC(alA); __syncthreads();
  }
  SBAR(); qkt(pB0, pB1, (bf16_t*)((char*)K_lds + SHM_K), qr, r32, hi);
  finishSM(pA0, pA1, alA, l_reg, pa0, pa1, pa2, pa3); SBAR();
  pv_d0(o, vb0, pa0, pa1, pa2, pa3); partialSM(pB0, pB1, m_reg, mnB, alB);
  __syncthreads(); RESC(alB);
  finishSM(pB0, pB1, alB, l_reg, pa0, pa1, pa2, pa3); SBAR();
  pv_d0(o, vb0 + (int)SHM_V, pa0, pa1, pa2, pa3);
  if (hi == 0) li_l[r32] = l_reg; asm volatile("s_waitcnt lgkmcnt(0)" ::: "memory");
  float rli[16];
#pragma unroll
  for (int r = 0; r < 16; ++r) rli[r] = __builtin_amdgcn_rcpf(li_l[crow(r, hi)]);
  bf16_t* Ow = Ob + (long)(wid * QBLK) * LDO;
#pragma unroll
  for (int r = 0; r < 16; ++r) { int orow = crow(r, hi);
    for (int d0 = 0; d0 < 4; ++d0) Ow[(long)orow * LDO + d0 * 32 + r32] = f2bf(o[d0][r] * rli[r]); }
  asm volatile("s_waitcnt vmcnt(0) lgkmcnt(0)" ::: "memory");
  __syncthreads();
#undef SLOAD
#undef SWRITE
#undef SWAIT
#undef RESC
}
#undef KSWZ
#undef SBAR
}

#define XB_TMO      128
#define XB_XCNT(j)  (256  + 64 * (j))
#define XB_XSUB(j)  (1280 + 64 * (j))
#define XB_XGEN(j)  (2304 + 64 * (j))
#define XB_TOP      3328
#define XB_TOPGEN   3392
#define XCD_BAR_WORDS 3456
#define XB_SPIN_CAP (1u << 18)
__device__ __forceinline__ unsigned xb_ld(unsigned* p)              { return __hip_atomic_load(p, __ATOMIC_RELAXED, __HIP_MEMORY_SCOPE_AGENT); }
__device__ __forceinline__ unsigned xb_add(unsigned* p, unsigned v) { return __hip_atomic_fetch_add(p, v, __ATOMIC_RELAXED, __HIP_MEMORY_SCOPE_AGENT); }
__device__ __forceinline__ unsigned xb_xcc_id() { return (unsigned)__builtin_amdgcn_s_getreg((3 << 11) | 20) & 0xFu; }
#define XB_SPIN(cond, bar) do { unsigned _sp = 0; while (cond) { __builtin_amdgcn_s_sleep(1); \
    if ((++_sp & 255u) == 0u) { if (xb_ld(&(bar)[XB_TMO])) break; if (_sp > XB_SPIN_CAP) { atomicAdd(&(bar)[XB_TMO], 1u); break; } } } } while (0)
struct XcdBarrier { unsigned* bar; unsigned x; volatile LAS unsigned* st; };
__device__ __forceinline__ XcdBarrier xcd_barrier_post(unsigned* bar, volatile LAS unsigned* st) {
    XcdBarrier b; b.bar = bar; b.x = xb_xcc_id(); b.st = st;
    if (threadIdx.x == 0) (void)xb_add(&bar[XB_XCNT(b.x)], 1u);
    return b;
}
__device__ __forceinline__ void xcd_barrier_complete(unsigned* bar, unsigned x, unsigned& nloc, unsigned& nx) {
    const unsigned G = gridDim.x * gridDim.y * gridDim.z;
    unsigned sum, cnt, mine, sp = 0u;
    for (;;) {
        sum = 0u; cnt = 0u; mine = 0u;
#pragma unroll
        for (unsigned j = 0; j < 16; ++j) { const unsigned c = xb_ld(&bar[XB_XCNT(j)]); sum += c; cnt += (c > 0u) ? 1u : 0u; mine = (j == x) ? c : mine; }
        if (sum == G) break;
        __builtin_amdgcn_s_sleep(1);
        if ((++sp & 255u) == 0u) { if (xb_ld(&bar[XB_TMO])) break; if (sp > XB_SPIN_CAP) { atomicAdd(&bar[XB_TMO], 1u); break; } }
    }
    nloc = mine > 0u ? mine : 1u; nx = cnt > 0u ? cnt : 1u;
}
__device__ __forceinline__ void xcd_barrier(const XcdBarrier& b) {
    asm volatile("s_waitcnt vmcnt(0)" ::: "memory");
    __syncthreads();
    if (threadIdx.x == 0) {
        unsigned* bar = b.bar;
        __builtin_amdgcn_s_waitcnt(0);
        unsigned nloc = b.st[0], nx = b.st[1];
        if (nloc == 0u) { xcd_barrier_complete(bar, b.x, nloc, nx); b.st[0] = nloc; b.st[1] = nx; }
        const unsigned old = xb_add(&bar[XB_XSUB(b.x)], 1u);
        const unsigned gen = old / nloc;
        if (old + 1u == (gen + 1u) * nloc) {
            __builtin_amdgcn_fence(__ATOMIC_RELEASE, "agent");
            asm volatile("s_waitcnt vmcnt(0)" ::: "memory");
            const unsigned og = xb_add(&bar[XB_TOP], 1u);
            const unsigned tg = og / nx;
            if (og + 1u == (tg + 1u) * nx) xb_add(&bar[XB_TOPGEN], 1u);
            else XB_SPIN(xb_ld(&bar[XB_TOPGEN]) == tg, bar);
            __builtin_amdgcn_fence(__ATOMIC_ACQUIRE, "agent");
            xb_add(&bar[XB_XGEN(b.x)], 1u);
            asm volatile("s_waitcnt vmcnt(0)" ::: "memory");
        } else {
            XB_SPIN(xb_ld(&bar[XB_XGEN(b.x)]) == gen, bar);
            __builtin_amdgcn_fence(__ATOMIC_ACQUIRE, "agent");
            asm volatile("s_waitcnt vmcnt(0)" ::: "memory");
        }
    }
    __syncthreads();
}

struct Args { const float* in[30]; float* out; unsigned char* ws; int ph_lo, ph_hi; };
enum { I_X = 0, I_C, I_CTX, I_CCTX, I_WADA, I_BADA, I_WIN, I_QG, I_KG, I_POOLW, I_POOLS, I_SLNG, I_SLNB, I_SGUW, I_SGUB, I_CONVW,
       I_WBRA, I_WBRP, I_WBRS, I_WBRC, I_WGATE, I_BGATE, I_WO, I_LN1G, I_LN1B, I_WFG, I_WFU, I_WFD, I_LN2G, I_LN2B };

__device__ __forceinline__ void phase_mods(const Args& a, char* lds, int G) {
    const int tid = opaque_tid();
    float* sc = (float*)lds;
    float* red = (float*)(lds + 9 * 2048 * 4);
    for (int i = tid; i < 9 * 2048; i += 512) { const int r = i >> 11, k = i & 2047; const float v = r < 8 ? a.in[I_C][r * 2048 + k] : a.in[I_CCTX][k]; sc[i] = v * sigmoidf_(v); }
    __syncthreads();
    float* mod = (float*)(a.ws + WS_MOD);
    const int lane = tid & 63, wave = tid >> 6, c4 = (lane & 15) * 4, kr = lane >> 4;
    for (int it = blockIdx.x; it < 2 * (MODW / 64); it += G) {
        const int l = it / (MODW / 64), n0 = (it % (MODW / 64)) * 64;
        const float* W = a.in[I_WADA] + (size_t)l * DM * MODW + n0 + c4;
        f32x4 acc[9];
#pragma unroll
        for (int r = 0; r < 9; ++r) acc[r] = (f32x4){0.f, 0.f, 0.f, 0.f};
#pragma unroll 8
        for (int i = 0; i < 64; ++i) { const int k = wave * 256 + i * 4 + kr; const f32x4 w = __builtin_nontemporal_load((const f32x4*)(W + (size_t)k * MODW));
#pragma unroll
            for (int r = 0; r < 9; ++r) acc[r] += w * sc[r * 2048 + k]; }
#pragma unroll
        for (int r = 0; r < 9; ++r)
#pragma unroll
            for (int e = 0; e < 4; ++e) { float v = acc[r][e]; v += __shfl_xor(v, 16); v += __shfl_xor(v, 32); acc[r][e] = v; }
        if (kr == 0) {
#pragma unroll
            for (int r = 0; r < 9; ++r) *(f32x4*)(red + (wave * 9 + r) * 64 + c4) = acc[r]; }
        __syncthreads();
        for (int i = tid; i < 9 * 64; i += 512) { const int r = i >> 6, cc = i & 63; float sm = 0.f;
#pragma unroll
            for (int g = 0; g < 8; ++g) sm += red[(g * 9 + r) * 64 + cc];
            mod[((size_t)l * 9 + r) * MODW + n0 + cc] = sm + a.in[I_BADA][l * MODW + n0 + cc]; }
        __syncthreads();
    }
    if (blockIdx.x == G - 1) {
        float* rope = (float*)(a.ws + WS_ROPE);
        for (int i = tid; i < 64 * 32; i += 512) { const int pos = i >> 5, j = i & 31;
            const float inv = exp2f(-(float)(2 * j) / 64.f * 13.287712379549449f);
            const float ang = (float)pos * inv; const float turns = ang * 0.15915494309189535f; const float fr = turns - floorf(turns);
            rope[2 * i] = __builtin_amdgcn_cosf(fr); rope[2 * i + 1] = __builtin_amdgcn_sinf(fr); }
    }
}

__device__ __forceinline__ void tr_item(const float* W, int N, bf16_t* WT, int ldd, int drow0, int dk0, int k0, int n0, float* scr, int lane) {
    { const int r = lane >> 3, c4 = (lane & 7) * 4; f32x4 v[8];
#pragma unroll
        for (int i = 0; i < 8; ++i) v[i] = __builtin_nontemporal_load((const f32x4*)(W + (size_t)(k0 + r + 8 * i) * N + n0 + c4));
#pragma unroll
        for (int i = 0; i < 8; ++i) { float* d = scr + (r + 8 * i) * 33 + c4; d[0] = v[i][0]; d[1] = v[i][1]; d[2] = v[i][2]; d[3] = v[i][3]; } }
    LDS_WAIT(); asm volatile("" ::: "memory");
    const int c = lane & 7;
#pragma unroll
    for (int j = 0; j < 4; ++j) { const int n = (lane >> 3) + 8 * j; const float* s = scr + (8 * c) * 33 + n;
        u32x4 o; o.x = cvt_pk_bf16(s[0 * 33], s[1 * 33]); o.y = cvt_pk_bf16(s[2 * 33], s[3 * 33]); o.z = cvt_pk_bf16(s[4 * 33], s[5 * 33]); o.w = cvt_pk_bf16(s[6 * 33], s[7 * 33]);
        *(u32x4*)(WT + (size_t)(drow0 + n0 + n) * ldd + dk0 + k0 + 8 * c) = o; }
    LDS_WAIT(); asm volatile("" ::: "memory");
}
__device__ __forceinline__ void tr_item8(const float* W, int N, unsigned char* WT, int k0, int n0, float* scr, int lane) {
    { const int r = lane >> 3, c4 = (lane & 7) * 4; f32x4 v[8];
#pragma unroll
        for (int i = 0; i < 8; ++i) v[i] = __builtin_nontemporal_load((const f32x4*)(W + (size_t)(k0 + r + 8 * i) * N + n0 + c4));
#pragma unroll
        for (int i = 0; i < 8; ++i) { float* d = scr + (r + 8 * i) * 33 + c4; d[0] = v[i][0]; d[1] = v[i][1]; d[2] = v[i][2]; d[3] = v[i][3]; } }
    LDS_WAIT(); asm volatile("" ::: "memory");
    const int c = lane & 7;
#pragma unroll
    for (int j = 0; j < 4; ++j) { const int n = (lane >> 3) + 8 * j; const float* sp = scr + (8 * c) * 33 + n;
        unsigned lo = 0, hi = 0;
        lo = __builtin_amdgcn_cvt_pk_fp8_f32(sp[0 * 33] * WG8_SCALE, sp[1 * 33] * WG8_SCALE, lo, false); lo = __builtin_amdgcn_cvt_pk_fp8_f32(sp[2 * 33] * WG8_SCALE, sp[3 * 33] * WG8_SCALE, lo, true);
        hi = __builtin_amdgcn_cvt_pk_fp8_f32(sp[4 * 33] * WG8_SCALE, sp[5 * 33] * WG8_SCALE, hi, false); hi = __builtin_amdgcn_cvt_pk_fp8_f32(sp[6 * 33] * WG8_SCALE, sp[7 * 33] * WG8_SCALE, hi, true);
        u32x2 o; o.x = lo; o.y = hi;
        *(u32x2*)(WT + (size_t)(n0 + n) * 4096 + k0 + 8 * c) = o; }
    LDS_WAIT(); asm volatile("" ::: "memory");
}
constexpr int PI1 = 32 * 144, PI2 = 32 * 256, PI3 = 16 * 64, PI4 = 8 * 64, PI5 = 8 * 64, PI6 = 32 * 64, PI7 = 32 * 176, PI8 = 32 * 176, PI9 = 88 * 64;
constexpr int PNIT = PI1 + PI2 + PI3 + PI4 + PI5 + PI6 + PI7 + PI8 + PI9, PIT_WA = PI1 + PI2, PIT_WE = PNIT - PI9;
__device__ __forceinline__ void prep_items(const Args& a, char* lds, int l, int it_lo, int it_hi, int wk, int nw) {
    const int tid = opaque_tid(), lane = tid & 63, wave = tid >> 6;
    float* scr = (float*)(lds + wave * 16384);
    bf16_t* WA = (bf16_t*)(a.ws + WS_WA); bf16_t* WB = (bf16_t*)(a.ws + WS_WB); bf16_t* WC = (bf16_t*)(a.ws + WS_WC);
    bf16_t* WD = (bf16_t*)(a.ws + WS_WD); bf16_t* WE = (bf16_t*)(a.ws + WS_WE);
    for (int it = it_lo + wk; it < it_hi; it += nw) {
        int r = it;
        if (r < PI1) { const int nb = r % 144, kb = r / 144; tr_item(a.in[I_WIN] + (size_t)l * DM * INW, INW, WA, DM, 0, 0, kb * 64, nb * 32, scr, lane); continue; } r -= PI1;
        if (r < PI2) { const int nb = r % 256, kb = r / 256; tr_item8(a.in[I_WGATE] + (size_t)l * DM * GW, GW, (unsigned char*)(a.ws + WS_WG8), kb * 64, nb * 32, scr, lane); continue; } r -= PI2;
        if (r < PI3) { const int nb = r % 64, kb = r / 64; tr_item(a.in[I_WBRA] + (size_t)l * 1024 * DM, DM, WB, BRK, 0, 0, kb * 64, nb * 32, scr, lane); continue; } r -= PI3;
        if (r < PI4) { const int nb = r % 64, kb = r / 64; tr_item(a.in[I_WBRS] + (size_t)l * 512 * DM, DM, WB, BRK, 0, 1536, kb * 64, nb * 32, scr, lane); continue; } r -= PI4;
        if (r < PI5) { const int nb = r % 64, kb = r / 64; tr_item(a.in[I_WBRC] + (size_t)l * 512 * DM, DM, WB, BRK, 0, 2048, kb * 64, nb * 32, scr, lane); continue; } r -= PI5;
        if (r < PI6) { const int nb = r % 64, kb = r / 64; tr_item(a.in[I_WO] + (size_t)l * DM * DM, DM, WC, DM, 0, 0, kb * 64, nb * 32, scr, lane); continue; } r -= PI6;
        if (r < PI7) { const int nb = r % 176, kb = r / 176; const int n0 = nb * 32; tr_item(a.in[I_WFG] + (size_t)l * DM * DFF, DFF, WD, DM, (n0 >> 7) * 256 + (n0 & 127) - n0, 0, kb * 64, n0, scr, lane); continue; } r -= PI7;
        if (r < PI8) { const int nb = r % 176, kb = r / 176; const int n0 = nb * 32; tr_item(a.in[I_WFU] + (size_t)l * DM * DFF, DFF, WD, DM, (n0 >> 7) * 256 + 128 + (n0 & 127) - n0, 0, kb * 64, n0, scr, lane); continue; } r -= PI8;
        { const int nb = r % 64, kb = r / 64; tr_item(a.in[I_WFD] + (size_t)l * DFF * DM, DM, WE, DFF, 0, 0, kb * 64, nb * 32, scr, lane); }
    }
}
__device__ __forceinline__ void prep_poolfold(const Args& a, int l, int wg, int nwg) {
    const int tid = opaque_tid();
    bf16_t* WB = (bf16_t*)(a.ws + WS_WB);
    const float* pw = a.in[I_POOLW] + (size_t)l * 4 * 128 * 128; const float* ps = a.in[I_POOLS] + (size_t)l * 512; const float* wbp = a.in[I_WBRP] + (size_t)l * 512 * DM;
    for (int it = wg; it < 128; it += nwg) {
        const int g = it >> 5, n = (it & 31) * 64 + (tid & 63), k16 = (tid >> 6) * 16;
        float acc[16];
#pragma unroll
        for (int q = 0; q < 16; ++q) acc[q] = 0.f;
        for (int j = 0; j < 128; ++j) { const float w = wbp[(size_t)(g * 128 + j) * DM + n] * ps[g * 128 + j];
#pragma unroll
            for (int q = 0; q < 16; ++q) acc[q] += pw[((size_t)g * 128 + k16 + q) * 128 + j] * w; }
        u32x4 o0, o1;
        o0.x = cvt_pk_bf16(acc[0], acc[1]); o0.y = cvt_pk_bf16(acc[2], acc[3]); o0.z = cvt_pk_bf16(acc[4], acc[5]); o0.w = cvt_pk_bf16(acc[6], acc[7]);
        o1.x = cvt_pk_bf16(acc[8], acc[9]); o1.y = cvt_pk_bf16(acc[10], acc[11]); o1.z = cvt_pk_bf16(acc[12], acc[13]); o1.w = cvt_pk_bf16(acc[14], acc[15]);
        bf16_t* dst = WB + (size_t)n * BRK + 1024 + g * 128 + k16;
        *(u32x4*)dst = o0; *(u32x4*)(dst + 8) = o1;
    }
}

__device__ __forceinline__ void phase_rows(const Args& a, int G, int mode, int nrows, const float* lng, const float* lnb, const float* modg, int goff,
                                           const float* xl_src, const float* xc_src, const float* modh, int sh_off, int sc_off, float* xl_out, bool w8) {
    unsigned char* H8 = a.ws + WS_H8;
    const int tid = opaque_tid(), lane = tid & 63, wave = tid >> 6;
    const int gw = blockIdx.x * 8 + wave, NGW = G * 8;
    const bf16_t* MB = (const bf16_t*)(a.ws + WS_P); float* xc_out = (float*)(a.ws + WS_XC); bf16_t* H = (bf16_t*)(a.ws + WS_H);
    f32x4 lg_[8], lb_[8];
    if (mode != 0) {
#pragma unroll
        for (int j = 0; j < 8; ++j) { const int c = 4 * (lane + 64 * j); lg_[j] = *(const f32x4*)(lng + c); lb_[j] = *(const f32x4*)(lnb + c); } }
    f32x4 v[8];
    if (gw < nrows) { const float* src = gw < ML ? xl_src + (size_t)gw * DM : xc_src + (size_t)(gw - ML) * DM;
#pragma unroll
        for (int j = 0; j < 8; ++j) v[j] = __builtin_nontemporal_load((const f32x4*)(src + 4 * (lane + 64 * j))); }
    for (int m = gw; m < nrows; m += NGW) {
        const int mrow = m < ML ? (m >> 11) : 8;
        f32x4 scv[8], shv[8];
        if (mode != 2) { const float* mr = modh + (size_t)mrow * MODW;
#pragma unroll
            for (int j = 0; j < 8; ++j) { const int c = 4 * (lane + 64 * j); scv[j] = *(const f32x4*)(mr + sc_off + c); shv[j] = *(const f32x4*)(mr + sh_off + c); } }
        if (mode != 0) {
            const bf16_t* mb = MB + (size_t)m * DM; const float* gr = modg + (size_t)mrow * MODW + goff;
            float s = 0.f;
#pragma unroll
            for (int j = 0; j < 8; ++j) { const int c = 4 * (lane + 64 * j); const u32x2 w = __builtin_nontemporal_load((const u32x2*)(mb + c)); const f32x4 g = *(const f32x4*)(gr + c);
                const f32x4 mv = {bflo(w.x), bfhi(w.x), bflo(w.y), bfhi(w.y)};
                v[j] = v[j] * ALPHA + g * mv; s += (v[j][0] + v[j][1]) + (v[j][2] + v[j][3]); }
            const float mean = wave_sum(s) * (1.f / DM); float s2 = 0.f;
#pragma unroll
            for (int j = 0; j < 8; ++j) { v[j] = v[j] - mean; s2 += (v[j][0] * v[j][0] + v[j][1] * v[j][1]) + (v[j][2] * v[j][2] + v[j][3] * v[j][3]); }
            const float rstd = 1.f / sqrtf(wave_sum(s2) * (1.f / DM) + LN_EPS);
#pragma unroll
            for (int j = 0; j < 8; ++j) v[j] = v[j] * rstd * lg_[j] + lb_[j];
        }
        const int mn = m + NGW; f32x4 vn[8];
        if (mn < nrows) { const float* srcn = mn < ML ? xl_src + (size_t)mn * DM : xc_src + (size_t)(mn - ML) * DM;
#pragma unroll
            for (int j = 0; j < 8; ++j) vn[j] = __builtin_nontemporal_load((const f32x4*)(srcn + 4 * (lane + 64 * j))); }
        if (mode != 0) { float* xo = m < ML ? xl_out + (size_t)m * DM : xc_out + (size_t)(m - ML) * DM;
#pragma unroll
            for (int j = 0; j < 8; ++j) __builtin_nontemporal_store(v[j], (f32x4*)(xo + 4 * (lane + 64 * j))); }
        if (mode != 2) {
#pragma unroll
            for (int j = 0; j < 8; ++j) { const int c = 4 * (lane + 64 * j);
                const f32x4 h = v[j] * (scv[j] + 1.f) + shv[j]; u32x2 w; w.x = cvt_pk_bf16(h[0], h[1]); w.y = cvt_pk_bf16(h[2], h[3]);
                *(u32x2*)(H + (size_t)m * DM + c) = w;
                if (w8) { unsigned q = 0; q = __builtin_amdgcn_cvt_pk_fp8_f32(h[0], h[1], q, false); q = __builtin_amdgcn_cvt_pk_fp8_f32(h[2], h[3], q, true); *(unsigned*)(H8 + (size_t)m * 4096 + c) = q; } }
        }
        if (mn < nrows) {
#pragma unroll
            for (int j = 0; j < 8; ++j) v[j] = vn[j]; }
    }
}

__device__ __forceinline__ void unpack8(const u32x4 w, float* f) { f[0] = bflo(w.x); f[1] = bfhi(w.x); f[2] = bflo(w.y); f[3] = bfhi(w.y); f[4] = bflo(w.z); f[5] = bfhi(w.z); f[6] = bflo(w.w); f[7] = bfhi(w.w); }
__device__ __forceinline__ u32x4 pack8(const float* f) { u32x4 w; w.x = cvt_pk_bf16(f[0], f[1]); w.y = cvt_pk_bf16(f[2], f[3]); w.z = cvt_pk_bf16(f[4], f[5]); w.w = cvt_pk_bf16(f[6], f[7]); return w; }

__device__ __forceinline__ void phase_local(const Args& a, char* lds, int G, int l) {
    const int tid = opaque_tid(), lane = tid & 63, wave = tid >> 6;
    const bf16_t* P = (const bf16_t*)(a.ws + WS_P); bf16_t* BR = (bf16_t*)(a.ws + WS_BR); bf16_t* QB = (bf16_t*)(a.ws + WS_QB);
    bf16_t* KB = (bf16_t*)(a.ws + WS_KB); bf16_t* VB = (bf16_t*)(a.ws + WS_VB);
    const float* rope = (const float*)(a.ws + WS_ROPE);
    const float* qg = a.in[I_QG] + l * 128; const float* kg = a.in[I_KG] + l * 128;
    const float* slng = a.in[I_SLNG] + l * 512; const float* slnb = a.in[I_SLNB] + l * 512;
    const float* sguw = a.in[I_SGUW] + (size_t)l * 4 * 128 * 128; const float* sgub = a.in[I_SGUB] + l * 512;
    const float* convw = a.in[I_CONVW] + l * 3 * 512;
    const bool last = (l == 1);
    const int nfull = last ? 128 : 144;
    const int nitems = nfull * 7 + (last ? 16 : 0);
    for (int it = blockIdx.x; it < nitems; it += G) {
        int ci, task;
        if (it < nfull * 7) { task = it / nfull; ci = it % nfull; } else { task = 0; ci = 128 + (it - nfull * 7); }
        int b, t0, n, m0;
        if (ci < 128) { b = ci >> 4; t0 = (ci & 15) * 128; n = SEQ; m0 = ci * 128; }
        else { const int cj = ci - 128; b = cj >> 1; t0 = (cj & 1) * 128; n = CTXL; m0 = ML + cj * 128; }
        const bool isctx = ci >= 128;
        if (task == 0) {
            const int hs = lane >> 4, i16 = lane & 15, e0 = i16 * 8;
            float gq[8], gk[8];
#pragma unroll
            for (int e = 0; e < 8; ++e) { gq[e] = qg[e0 + e]; gk[e] = kg[e0 + e]; }
            const bool lower = (i16 & 4) == 0;
            const int hg0 = (isctx && last) ? 2 : 0;
            for (int i = 0; i < 16; i += 2) {
                u32x4 raw[2][3], vraw[2]; f32x4 rp[2][4];
#pragma unroll
                for (int tk = 0; tk < 2; ++tk) { const size_t m = (size_t)m0 + wave * 16 + i + tk; const bf16_t* pr = P + m * INW;
#pragma unroll
                    for (int hg = 0; hg < 3; ++hg) if (hg >= hg0) raw[tk][hg] = *(const u32x4*)(pr + (hg * 4 + hs) * 128 + e0);
                    vraw[tk] = *(const u32x4*)(pr + 1280 + (lane & 31) * 8);
                    if (!isctx) { const int t = t0 + wave * 16 + i + tk; const int pos = i16 < 8 ? (t >> 6) : (t & 63); const float* rr = rope + (pos * 32 + 8 * (i16 & 3)) * 2;
#pragma unroll
                        for (int q = 0; q < 4; ++q) rp[tk][q] = *(const f32x4*)(rr + 4 * q); } }
#pragma unroll
                for (int tk = 0; tk < 2; ++tk) { const int tt = wave * 16 + i + tk, t = t0 + tt; const size_t m = (size_t)m0 + tt;
                    const int kvpos = isctx ? t : CTXL + t; const size_t kvrow = ((size_t)b * KVLEN + kvpos) * 256;
#pragma unroll
                    for (int hg = 0; hg < 3; ++hg) if (hg >= hg0) {
                        const int head = hg * 4 + hs;
                        float x[8]; unpack8(raw[tk][hg], x);
                        float ss = 0.f;
#pragma unroll
                        for (int e = 0; e < 8; ++e) ss += x[e] * x[e];
                        ss += __shfl_xor(ss, 1); ss += __shfl_xor(ss, 2); ss += __shfl_xor(ss, 4); ss += __shfl_xor(ss, 8);
                        const float r = 1.f / sqrtf(ss * (1.f / 128.f) + RMS_EPS);
                        float o[8];
#pragma unroll
                        for (int e = 0; e < 8; ++e) o[e] = x[e] * r * (hg < 2 ? gq[e] : gk[e]);
                        if (!isctx) {
#pragma unroll
                            for (int e = 0; e < 8; ++e) { const float pn = __shfl_xor(o[e], 4); const float cs = rp[tk][e >> 1][(e & 1) * 2], sn = rp[tk][e >> 1][(e & 1) * 2 + 1];
                                o[e] = lower ? o[e] * cs - pn * sn : o[e] * cs + pn * sn; } }
                        if (hg < 2) *(u32x4*)(QB + m * 1024 + head * 128 + e0) = pack8(o);
                        else if (hs < 2) *(u32x4*)(KB + kvrow + hs * 128 + e0) = pack8(o);
                    }
                    if (lane < 32) *(u32x4*)(VB + kvrow + lane * 8) = vraw[tk];
                }
            }
        } else if (task == 1) {
            const int g = wave >> 1, vec = lane & 15, sub = (lane >> 4) + 4 * (wave & 1), ch0 = g * 128 + vec * 8;
            const int w = 2 << g, left = w >> 1;
            const bf16_t* zb = P + ((size_t)m0 - t0) * INW + 1536 + ch0;
            for (int k = 0; k < 16; ++k) { const int tt = k * 8 + sub, t = t0 + tt;
                const u32x4 zc = *(const u32x4*)(zb + (size_t)t * INW);
                float s[8] = {0.f, 0.f, 0.f, 0.f, 0.f, 0.f, 0.f, 0.f}, z[8], f[8]; int cnt = 0;
#pragma unroll
                for (int hq = 0; hq < 16; hq += 8) if (hq < w) {
                    u32x4 rw[8];
#pragma unroll
                    for (int q = 0; q < 8; ++q) { int row = t - left + hq + q; row = row < 0 ? 0 : (row > n - 1 ? n - 1 : row); if (hq + q < w) rw[q] = *(const u32x4*)(zb + (size_t)row * INW); }
#pragma unroll
                    for (int q = 0; q < 8; ++q) if (hq + q < w) { const int row = t - left + hq + q; if (row >= 0 && row < n) { unpack8(rw[q], f); ++cnt;
#pragma unroll
                            for (int e = 0; e < 8; ++e) s[e] += f[e]; } } }
                unpack8(zc, z);
                const float inv = 1.f / (float)cnt;
#pragma unroll
                for (int e = 0; e < 8; ++e) f[e] = s[e] * inv - z[e];
                *(u32x4*)(BR + ((size_t)m0 + tt) * BRK + 1024 + ch0) = pack8(f); }
        } else if (task == 2) {
            float cw0[8], cw1[8], cw2[8]; const int vecc = tid & 63, chc = vecc * 8;
#pragma unroll
            for (int e = 0; e < 8; ++e) { cw0[e] = convw[chc + e]; cw1[e] = convw[512 + chc + e]; cw2[e] = convw[1024 + chc + e]; }
            for (int k = 0; k < 16; k += 2) {
                u32x4 ld[2][7];
#pragma unroll
                for (int u = 0; u < 2; ++u) { const int tt = (tid >> 6) + 8 * (k + u), t = t0 + tt; const bf16_t* pr = P + ((size_t)m0 + tt) * INW;
                    const bf16_t* pm = t > 0 ? pr - INW : pr; const bf16_t* pp = t < n - 1 ? pr + INW : pr;
                    ld[u][0] = *(const u32x4*)(pr + 3072 + chc); ld[u][1] = *(const u32x4*)(pr + 3584 + chc); ld[u][2] = *(const u32x4*)(pr + 4096 + chc);
                    ld[u][3] = *(const u32x4*)(pm + 3584 + chc); ld[u][4] = *(const u32x4*)(pm + 4096 + chc);
                    ld[u][5] = *(const u32x4*)(pp + 3584 + chc); ld[u][6] = *(const u32x4*)(pp + 4096 + chc); }
#pragma unroll
                for (int u = 0; u < 2; ++u) { const int tt = (tid >> 6) + 8 * (k + u), t = t0 + tt;
                    float cb[8], cc[8], cx[8], a1[8], a2[8], b1[8], b2[8], f[8];
                    unpack8(ld[u][0], cb); unpack8(ld[u][1], cc); unpack8(ld[u][2], cx); unpack8(ld[u][3], a1); unpack8(ld[u][4], a2); unpack8(ld[u][5], b1); unpack8(ld[u][6], b2);
                    const float mm = t > 0 ? 1.f : 0.f, mp = t < n - 1 ? 1.f : 0.f;
#pragma unroll
                    for (int e = 0; e < 8; ++e) f[e] = cb[e] * ((a1[e] * a2[e]) * (mm * cw0[e]) + (cc[e] * cx[e]) * cw1[e] + (b1[e] * b2[e]) * (mp * cw2[e]));
                    *(u32x4*)(BR + ((size_t)m0 + tt) * BRK + 2048 + chc) = pack8(f); }
            }
        } else {
            const int g = task - 3;
            bf16_t* Vt = (bf16_t*)lds;
            bf16_t* Ws = (bf16_t*)(lds + 128 * 272);
            u32x4 vr[16];
#pragma unroll
            for (int i = 0; i < 16; ++i) vr[i] = *(const u32x4*)(P + ((size_t)m0 + wave * 16 + i) * INW + 2560 + lane * 8);
            float lg[8], lb[8];
            { const int c0 = (lane & 15) * 8;
#pragma unroll
                for (int e = 0; e < 8; ++e) { lg[e] = slng[g * 128 + c0 + e]; lb[e] = slnb[g * 128 + c0 + e]; } }
#pragma unroll
            for (int i = 0; i < 16; ++i) { const int q = wave * 16 + i; float f[8];
                unpack8(vr[i], f);
                float s = 0.f;
#pragma unroll
                for (int e = 0; e < 8; ++e) { f[e] = gelu_tanh(f[e]); s += f[e]; }
                const float mean = wave_sum(s) * (1.f / 512.f); float s2 = 0.f;
#pragma unroll
                for (int e = 0; e < 8; ++e) { f[e] -= mean; s2 += f[e] * f[e]; }
                const float rstd = 1.f / sqrtf(wave_sum(s2) * (1.f / 512.f) + LN_EPS);
                if ((lane >> 4) == g) { const int c0 = (lane & 15) * 8;
#pragma unroll
                    for (int e = 0; e < 8; ++e) Vt[(c0 + e) * 136 + q] = f2bf(f[e] * rstd * lg[e] + lb[e]); } }
            { const int p = tid >> 2, q0 = (tid & 3) * 32; const float* wsrc = sguw + ((size_t)g * 128 + p) * 128 + q0;
#pragma unroll
                for (int k = 0; k < 4; ++k) { const f32x4 x0 = *(const f32x4*)(wsrc + 8 * k), x1 = *(const f32x4*)(wsrc + 8 * k + 4);
                    u32x4 w; w.x = cvt_pk_bf16(x0[0], x0[1]); w.y = cvt_pk_bf16(x0[2], x0[3]); w.z = cvt_pk_bf16(x1[0], x1[1]); w.w = cvt_pk_bf16(x1[2], x1[3]);
                    *(u32x4*)(Ws + p * 136 + q0 + 8 * k) = w; } }
            __syncthreads();
            f32x4 acc[8]; u32x2 uw[8];
            { const int p = 16 * wave + (lane & 15); const size_t m = (size_t)m0 + p;
#pragma unroll
                for (int i = 0; i < 8; ++i) uw[i] = *(const u32x2*)(P + m * INW + 2048 + g * 128 + 16 * i + 4 * (lane >> 4)); }
#pragma unroll
            for (int i = 0; i < 8; ++i) acc[i] = (f32x4){0.f, 0.f, 0.f, 0.f};
#pragma unroll
            for (int kk = 0; kk < 4; ++kk) { const bf16x8 bw = *(const bf16x8*)(Ws + (16 * wave + (lane & 15)) * 136 + kk * 32 + (lane >> 4) * 8);
#pragma unroll
                for (int i = 0; i < 8; ++i) { const bf16x8 av = *(const bf16x8*)(Vt + (16 * i + (lane & 15)) * 136 + kk * 32 + (lane >> 4) * 8);
                    acc[i] = __builtin_amdgcn_mfma_f32_16x16x32_bf16(av, bw, acc[i], 0, 0, 0); } }
            { const int p = 16 * wave + (lane & 15); const size_t m = (size_t)m0 + p; const float bias = sgub[g * 128 + p];
#pragma unroll
                for (int i = 0; i < 8; ++i) { const int c = 16 * i + 4 * (lane >> 4);
                    const float y0 = gelu_tanh(bflo(uw[i].x)) * (acc[i][0] + bias), y1 = gelu_tanh(bfhi(uw[i].x)) * (acc[i][1] + bias);
                    const float y2 = gelu_tanh(bflo(uw[i].y)) * (acc[i][2] + bias), y3 = gelu_tanh(bfhi(uw[i].y)) * (acc[i][3] + bias);
                    u32x2 w; w.x = cvt_pk_bf16(y0, y1); w.y = cvt_pk_bf16(y2, y3);
                    *(u32x2*)(BR + m * BRK + 1536 + g * 128 + c) = w; } }
            __syncthreads();
        }
    }
}

__device__ __forceinline__ void phase_attn(const Args& a, char* lds, int G, int l) {
    const bf16_t* QB = (const bf16_t*)(a.ws + WS_QB); const bf16_t* KB = (const bf16_t*)(a.ws + WS_KB); const bf16_t* VB = (const bf16_t*)(a.ws + WS_VB);
    bf16_t* BR = (bf16_t*)(a.ws + WS_BR);
    const int c = blockIdx.x;
    for (int i = 0; i * G + c < 512; ++i) {
        int b, h, qb;
        if (G == 256) { const int grp = (c & 7) + 8 * i, j = c >> 3; b = grp >> 1; h = (grp & 1) * 4 + (j >> 3); qb = j & 7; }
        else { const int u = i * G + c; b = u >> 6; h = (u >> 3) & 7; qb = u & 7; }
        const size_t qrow = (size_t)b * SEQ + qb * 256;
        att::attn_dense_body(QB + qrow * 1024 + h * 128, KB + (size_t)b * KVLEN * 256 + (h >> 2) * 128, VB + (size_t)b * KVLEN * 256 + (h >> 2) * 128,
                             BR + qrow * BRK + h * 128, KVLEN, lds);
    }
    if (l == 0) for (int u = c; u < 64; u += G) {
        const int b = u >> 3, h = u & 7; const size_t qrow = (size_t)ML + b * CTXL;
        att::attn_dense_body(QB + qrow * 1024 + h * 128, KB + (size_t)b * KVLEN * 256 + (h >> 2) * 128, VB + (size_t)b * KVLEN * 256 + (h >> 2) * 128,
                             BR + qrow * BRK + h * 128, CTXL, lds);
    }
}

constexpr int NPHASE = 20;
__global__ void __launch_bounds__(512, 2) mega_fwd(Args a) {
    extern __shared__ __attribute__((aligned(16))) unsigned char lds[];
    const int G = gridDim.x, c = blockIdx.x;
    LAS unsigned char* ldsl = (LAS unsigned char*)lds;
    float* modb = (float*)(a.ws + WS_MOD);
    volatile LAS unsigned* bst = (volatile LAS unsigned*)(ldsl + 131072 + 512);
    if (threadIdx.x < 2) bst[threadIdx.x] = 0u;
    __syncthreads();
    XcdBarrier bar = xcd_barrier_post((unsigned*)(a.ws + WS_BAR), bst);
    if (a.ph_hi < 0) cg::this_grid().sync();
#define GRID_SYNC() xcd_barrier(bar)
    int rep = 0; (void)rep;
    for (int ph = a.ph_lo; ph < a.ph_hi; ++ph) {
        if (ph == 0) { phase_mods(a, (char*)lds, G); __syncthreads(); prep_items(a, (char*)lds, 0, 0, PIT_WA, c * 8 + (opaque_tid() >> 6), G * 8); }
        else if (ph == 1) { phase_rows(a, G, 0, MT, nullptr, nullptr, nullptr, 0, a.in[I_X], a.in[I_CTX], modb, 0, DM, nullptr, true); }
        else {
            const int l = (ph - 2) / 9, k = (ph - 2) % 9; const bool last = (l == 1);
            const float* mod = modb + (size_t)l * 9 * MODW;
            const int nM = last ? 64 : 72;
            if (k == 0) {
                {
                    pg8::SchedG S{(const char*)(a.ws + WS_H), (const char*)(a.ws + WS_WA), DM * 2, nM, 18, 32, G, c, last ? 16 : 0, 64, 4, 8, 0};
                    pg8::EpiP E{(bf16_t*)(a.ws + WS_P)};
                    pg8::gemm_phase(ldsl, DM, S, E); }
                {
                    pg8::SchedG S{(const char*)(a.ws + WS_H8), (const char*)(a.ws + WS_WG8), 4096, nM, 32, 16, G, c, 0, 0, 0, 1, 18};
                    pg8::EpiG E{(bf16_t*)(a.ws + WS_G), a.in[I_BGATE] + (size_t)l * GW};
                    pg8::gemm_phase<pg8::EpiG, pg8::SchedG, true>(ldsl, DM, S, E); }
                if (!last) { const int busy = (nM * 18) % G;
                    if (c >= busy) { prep_items(a, (char*)lds, 0, PIT_WA, PNIT, (c - busy) * 8 + (opaque_tid() >> 6), (G - busy) * 8); prep_poolfold(a, 0, c - busy, G - busy); } }
            } else if (k == 1) phase_local(a, (char*)lds, G, l);
            else if (k == 2) phase_attn(a, (char*)lds, G, l);
            else if (k == 3) {
                pg8::SchedSeg S{(const char*)(a.ws + WS_BR), (const char*)(a.ws + WS_WB), BRK, nM, 8, G, c};
                pg8::EpiB E{(bf16_t*)(a.ws + WS_H), (const bf16_t*)(a.ws + WS_G)};
                pg8::gemm_phase(ldsl, BRK, S, E);
            } else if (k == 4 || k == 7) {
                const bool mix = (k == 4);
                const int ld = mix ? DM : DFF;
                pg8::SchedG S{(const char*)(a.ws + (mix ? WS_H : WS_G)), (const char*)(a.ws + (mix ? WS_WC : WS_WE)), ld * 2, nM, 8, ld / 64, G, c, 0, 0, 0, 1, 0};
                pg8::EpiRaw E{(bf16_t*)(a.ws + WS_P), DM};
                pg8::gemm_phase(ldsl, ld, S, E);
                if (!last) { const int busy = (nM * 8) % G;
                    if (c >= busy) { const int wk = (c - busy) * 8 + (opaque_tid() >> 6), nw = (G - busy) * 8;
                        if (mix) prep_items(a, (char*)lds, 1, 0, PIT_WA, wk, nw);
                        else { prep_items(a, (char*)lds, 1, PIT_WA, PIT_WE, wk, nw); prep_poolfold(a, 1, c - busy, G - busy); } } }
            } else if (k == 5) phase_rows(a, G, 1, nM * 256, a.in[I_LN1G] + l * DM, a.in[I_LN1B] + l * DM, mod, 2 * DM,
                                          l == 0 ? a.in[I_X] : a.out, l == 0 ? a.in[I_CTX] : (const float*)(a.ws + WS_XC), mod, 3 * DM, 4 * DM, a.out, false);
            else if (k == 6) {
                pg8::SchedG S{(const char*)(a.ws + WS_H), (const char*)(a.ws + WS_WD), DM * 2, nM, 44, 32, G, c, 0, 0, 0, 1, 0};
                pg8::EpiSwiglu E{(bf16_t*)(a.ws + WS_G)};
                pg8::gemm_phase(ldsl, DM, S, E);
            } else {
                if (!last) { phase_rows(a, G, 1, MT, a.in[I_LN2G], a.in[I_LN2B], mod, 5 * DM, a.out, (const float*)(a.ws + WS_XC), modb + (size_t)9 * MODW, 0, DM, a.out, true); prep_items(a, (char*)lds, 1, PIT_WE, PNIT, c * 8 + (opaque_tid() >> 6), G * 8); }
                else phase_rows(a, G, 2, ML, a.in[I_LN2G] + DM, a.in[I_LN2B] + DM, mod, 5 * DM, a.out, nullptr, nullptr, 0, 0, a.out, false);
            }
        }
#ifdef PROBE_DUP
        {
            const int kk = ph < 2 ? -1 : (ph - 2) % 9;
            const bool isgemm = kk == 0 || kk == 3 || kk == 4 || kk == 6 || kk == 7, isattn = kk == 2;
            const bool dup = (PROBE_DUP == 1 && isgemm) || (PROBE_DUP == 3 && !isgemm && !isattn) || (PROBE_DUP == 4 && isattn) || (PROBE_DUP == 5 && kk == 1) || (PROBE_DUP == 6 && ph < 2) || (PROBE_DUP == 7 && kk == 0) || (PROBE_DUP == 8 && kk == 3) || (PROBE_DUP == 9 && kk == 6);
            if (PROBE_DUP == 2) GRID_SYNC();
            if (dup && rep == 0) { GRID_SYNC(); rep = 1; --ph; continue; }
            rep = 0;
        }
#endif
        if (ph + 1 < a.ph_hi) GRID_SYNC();
    }
#ifdef DBG_PH
    GRID_SYNC();
    {
        const int gt = blockIdx.x * 512 + threadIdx.x, NT = gridDim.x * 512;
        for (size_t i = gt; i < (size_t)ML * DM; i += NT) { const size_t m = i >> 11; const int cc = (int)(i & 2047);
#if DBG_KIND == 0
            a.out[i] = ((const float*)(a.ws + DBG_SRC))[m * DBG_LD + DBG_COL0 + cc];
#else
            a.out[i] = bf2f(((const bf16_t*)(a.ws + DBG_SRC))[m * DBG_LD + DBG_COL0 + cc]);
#endif
        }
    }
#endif
}

extern "C" void kernel_launch(void* const* d_in, const int* in_sizes, int n_in, void* d_out, int out_size, void* d_ws, size_t ws_size, hipStream_t stream) {
    static int grid = 0;
    if (grid == 0) {
        if (n_in != 30 || in_sizes[0] != ML * DM || out_size != ML * DM || ws_size < WS_END) {
            fprintf(stderr, "kernel_launch: unexpected shapes: n_in %d in0 %d out %d ws %zu (need %zu)\n", n_in, n_in > 0 ? in_sizes[0] : -1, out_size, ws_size, (size_t)WS_END); grid = -1; return; }
        int dev = 0, cus = 0, per_cu = 0;
        hipGetDevice(&dev); hipDeviceGetAttribute(&cus, hipDeviceAttributeMultiprocessorCount, dev);
        if (hipFuncSetAttribute((const void*)mega_fwd, hipFuncAttributeMaxDynamicSharedMemorySize, LDS_BYTES) != hipSuccess) { fprintf(stderr, "kernel_launch: hipFuncSetAttribute failed\n"); grid = -1; return; }
        if (hipOccupancyMaxActiveBlocksPerMultiprocessor(&per_cu, (const void*)mega_fwd, 512, LDS_BYTES) != hipSuccess || per_cu < 1) { fprintf(stderr, "kernel_launch: occupancy query gave %d\n", per_cu); per_cu = 1; }
        (void)hipGetLastError();
        grid = cus * per_cu;
        fprintf(stderr, "kernel_launch: grid %d (cus %d x %d)\n", grid, cus, per_cu);
    }
    if (grid < 0) return;
    Args a{};
    for (int i = 0; i < 30; ++i) a.in[i] = (const float*)d_in[i];
    a.out = (float*)d_out; a.ws = (unsigned char*)d_ws;
#if MK_ONE_LAUNCH
    (void)hipMemsetAsync((char*)d_ws + WS_BAR, 0, 16384, stream);
#ifdef DBG_PH
    a.ph_lo = 0; a.ph_hi = DBG_PH + 1;
#else
    a.ph_lo = 0; a.ph_hi = NPHASE;
#endif
    void* kargs[] = {&a};
    hipError_t e = hipLaunchCooperativeKernel((const void*)mega_fwd, dim3(grid), dim3(512), kargs, LDS_BYTES, stream);
    if (e != hipSuccess) fprintf(stderr, "cooperative launch failed: %s (grid %d)\n", hipGetErrorString(e), grid);
#else
    for (int ph = 0; ph < NPHASE; ++ph) {
        a.ph_lo = ph; a.ph_hi = ph + 1;
        hipLaunchKernelGGL(mega_fwd, dim3(grid), dim3(512), LDS_BYTES, stream, a);
    }
#endif
}
```

```cpp
#include <hip/hip_runtime.h>
#include <hip/hip_bf16.h>
#include <hip/hip_cooperative_groups.h>
#include <cstdio>
#include <cstdint>
namespace cg = cooperative_groups;

#ifndef MK_ONE_LAUNCH
#define MK_ONE_LAUNCH 1
#endif

#define LAS __attribute__((address_space(3)))
typedef unsigned short bf16_t;
typedef short bf16x8 __attribute__((ext_vector_type(8)));
typedef short s16x4 __attribute__((ext_vector_type(4)));
typedef float f32x4 __attribute__((ext_vector_type(4)));
typedef float f32x16 __attribute__((ext_vector_type(16)));
typedef unsigned u32x4 __attribute__((ext_vector_type(4)));
typedef unsigned u32x2 __attribute__((ext_vector_type(2)));
typedef int i32x4 __attribute__((ext_vector_type(4)));
typedef int i32x8 __attribute__((ext_vector_type(8)));

constexpr int DM = 2048, NBATCH = 8, SEQ = 2048, CTXL = 256;
constexpr int ML = NBATCH * SEQ, MC = NBATCH * CTXL, MT = ML + MC;
constexpr int INW = 4608, GW = 8192, NA = INW + GW, BRK = 2560, DFF = 5632, NDU = 2 * DFF;
constexpr int KVLEN = CTXL + SEQ;
constexpr int MODW = 6 * DM;
constexpr float ALPHA = 1.4142135623730951f;
constexpr float LN_EPS = 1e-5f, RMS_EPS = 1e-6f;

constexpr size_t MiB = 1u << 20;
constexpr size_t WS_ROPE = 0;
constexpr size_t WS_BAR = 65536;
constexpr size_t WS_MOD = 1 * MiB;
constexpr size_t WS_WA = 2 * MiB;
constexpr size_t WS_WB = WS_WA + 50 * MiB;
constexpr size_t WS_WC = WS_WB + 10 * MiB;
constexpr size_t WS_WD = WS_WC + 8 * MiB;
constexpr size_t WS_WE = WS_WD + 44 * MiB;
constexpr size_t WS_XC = WS_WE + 22 * MiB;
constexpr size_t WS_H = WS_XC + 16 * MiB;
constexpr size_t WS_P = WS_H + 72 * MiB;
constexpr size_t WS_G = WS_P + 162 * MiB;
constexpr size_t WS_BR = WS_G + 288 * MiB;
constexpr size_t WS_QB = WS_BR + 90 * MiB;
constexpr size_t WS_KB = WS_QB + 36 * MiB;
constexpr size_t WS_VB = WS_KB + 9 * MiB;
constexpr size_t WS_END = WS_VB + 9 * MiB;
constexpr size_t WS_H8 = WS_BR;
constexpr size_t WS_WG8 = WS_WA + 18 * MiB;
constexpr float WG8_SCALE = 64.f;

constexpr int LDS_BYTES = 147456;

typedef float f32x2_t __attribute__((ext_vector_type(2)));
typedef __bf16 bf16x2_t __attribute__((ext_vector_type(2)));
__device__ __forceinline__ unsigned cvt_pk_bf16(float lo, float hi) { f32x2_t v = {lo, hi}; bf16x2_t r = __builtin_convertvector(v, bf16x2_t); return __builtin_bit_cast(unsigned, r); }
__device__ __forceinline__ float bflo(unsigned w) { return __uint_as_float(w << 16); }
__device__ __forceinline__ float bfhi(unsigned w) { return __uint_as_float(w & 0xffff0000u); }
__device__ __forceinline__ float bf2f(bf16_t h) { return __uint_as_float((unsigned)h << 16); }
__device__ __forceinline__ bf16_t f2bf(float f) { return (bf16_t)(cvt_pk_bf16(f, 0.f) & 0xffffu); }
__device__ __forceinline__ float sigmoidf_(float x) { return __builtin_amdgcn_rcpf(1.f + __builtin_amdgcn_exp2f(-1.4426950408889634f * x)); }
__device__ __forceinline__ float gelu_tanh(float x) { const float z = 1.5957691216057308f * (x + 0.044715f * x * x * x); return x * sigmoidf_(z); }
__device__ __forceinline__ float wave_sum(float v) {
#pragma unroll
    for (int o = 1; o < 64; o <<= 1) v += __shfl_xor(v, o);
    return v;
}
#define LDS_WAIT() asm volatile("s_waitcnt lgkmcnt(0)" ::: "memory")
__device__ __forceinline__ int opaque_tid() { int t = threadIdx.x; asm volatile("" : "+v"(t)); return t; }

namespace pg8 {
constexpr int BM = 256, BK = 64, HALF = 128, HTB = HALF * BK * 2, STAGE_BYTES = 8 * HTB;
__host__ __device__ __forceinline__ int lds_byte(int r, int c) { const int st = (r >> 4) * 2 + (c >> 5), rr = r & 15, cc = c & 31, ob = rr * 64 + cc * 2; return st * 1024 + (ob ^ (((ob >> 9) & 1) << 5)); }
__host__ __device__ __forceinline__ void stage_rc(int b, int& R, int& C) { const int st = b / 1024, sb = b % 1024, swz = sb ^ (((sb >> 9) & 1) << 5); R = (st >> 1) * 16 + swz / 64; C = (st & 1) * 32 + (swz % 64) / 2; }
__host__ __device__ __forceinline__ int perm32(int rho) { const int n = rho >> 4, i = rho & 15; return 8 * (i >> 2) + 4 * n + (i & 3); }

struct Unit { int pm, pn, seg, nt, f8; const char* a; const char* b; };

__device__ __forceinline__ void tile_of(int L, int nM, int nN, int& pm, int& pn) {
    const int nwg = nM * nN; int wgid = L;
    { const int q = nwg / 8, r = nwg % 8, xcd = wgid % 8, off = wgid / 8; wgid = (xcd < r ? xcd * (q + 1) : r * (q + 1) + (xcd - r) * q) + off; }
    const int nig = 8 * nN, gid = wgid / nig, fm = gid * 8, gsz = (nM - fm) < 8 ? (nM - fm) : 8;
    pm = fm + ((wgid % nig) % gsz); pn = (wgid % nig) / gsz;
}

template <class Epi, class Sched, bool F8 = false>
__device__ __forceinline__ void gemm_phase(LAS unsigned char* lds, const int ld, const Sched& S, const Epi& E) {
    const int tid = opaque_tid(), wid = __builtin_amdgcn_readfirstlane(tid >> 6), lane = tid & 63, wr = wid >> 2, wc = wid & 3, fr = lane & 15, fq = lane >> 4;
    unsigned voffA[2], voffB[2];
#pragma unroll
    for (int i = 0; i < 2; ++i) { int R, C; stage_rc(tid * 16 + i * 8192, R, C); const int Rb = Epi::PERM ? ((R & ~31) + perm32(R & 31)) : R;
        voffA[i] = (unsigned)(R * ld + C) * 2u; voffB[i] = (unsigned)(Rb * ld + C) * 2u; }
    const size_t kstep = (size_t)(BK * 2);
    const size_t hstep = (size_t)HALF * ld * 2;
    const unsigned ldsw = (unsigned)wid * 1024u;
    const int aoff = lds_byte(wr * 64 + fr, fq * 8), boff = lds_byte(wc * 32 + fr, fq * 8);
#define PG8_SA(b, h) (((b) * 2 + (h)) * HTB)
#define PG8_SB(b, h) ((4 + (b) * 2 + (h)) * HTB)
#define PG8_STAGE(bufoff, gbase, voff) do { _Pragma("unroll") for (int _i = 0; _i < 2; ++_i) \
        __builtin_amdgcn_global_load_lds((const unsigned*)((const char*)(gbase) + (voff)[_i]), (LAS unsigned*)(lds + (bufoff) + ldsw + _i * 8192), 16, 0, 0); } while (0)
#define PG8_LD8(p) __builtin_shufflevector(*(const LAS i32x4*)(p), *(const LAS i32x4*)((p) + 1024), 0, 1, 2, 3, 4, 5, 6, 7)
#define PG8_LDA(dst, b, h) do { _Pragma("unroll") for (int m = 0; m < 4; ++m) dst[m] = PG8_LD8(lds + PG8_SA(b, h) + aoff + m * 2048); } while (0)
#define PG8_LDB(dst, b, h) do { _Pragma("unroll") for (int n = 0; n < 2; ++n) dst[n] = PG8_LD8(lds + PG8_SB(b, h) + boff + n * 2048); } while (0)
#define PG8_LO(x) __builtin_bit_cast(bf16x8, __builtin_shufflevector(x, x, 0, 1, 2, 3))
#define PG8_HI(x) __builtin_bit_cast(bf16x8, __builtin_shufflevector(x, x, 4, 5, 6, 7))
#define PG8_MMA16(ai, bj, At, Bt) do { __builtin_amdgcn_s_setprio(1); _Pragma("unroll") for (int m = 0; m < 4; ++m) _Pragma("unroll") for (int n = 0; n < 2; ++n) { \
        acc[ai][bj][m][n] = __builtin_amdgcn_mfma_f32_16x16x32_bf16(PG8_LO(Bt[n]), PG8_LO(At[m]), acc[ai][bj][m][n], 0, 0, 0); \
        acc[ai][bj][m][n] = __builtin_amdgcn_mfma_f32_16x16x32_bf16(PG8_HI(Bt[n]), PG8_HI(At[m]), acc[ai][bj][m][n], 0, 0, 0); } __builtin_amdgcn_s_setprio(0); } while (0)
#define PG8_MMA8(ai, bj, At, Bt) do { __builtin_amdgcn_s_setprio(1); _Pragma("unroll") for (int m = 0; m < 4; ++m) _Pragma("unroll") for (int n = 0; n < 2; ++n) \
        asm volatile("v_mfma_scale_f32_16x16x128_f8f6f4 %0, %1, %2, %0, %3, %3 op_sel_hi:[0,0,0]" : "+v"(acc[ai][bj][m][n]) : "v"(Bt[n]), "v"(At[m]), "v"(sc1)); \
        __builtin_amdgcn_s_setprio(0); } while (0)
#define PG8_WAIT_V(n) asm volatile("s_waitcnt vmcnt(" #n ")" ::: "memory")
#define PG8_WAIT_L(n) asm volatile("s_waitcnt lgkmcnt(" #n ")" ::: "memory")
#define PG8_BAR __builtin_amdgcn_s_barrier()
#define PG8_SCHED __builtin_amdgcn_sched_barrier(0)
#define PG8_KLOOP(MMA) for (int t = 0; t < nt; t += 2) { \
            const bool last = (t == nt - 2); \
            const char* a1 = cA + (size_t)(t + 1) * kstep; \
            const char* a2 = last ? nA : cA + (size_t)(t + 2) * kstep; const char* b2 = last ? nB : cB + (size_t)(t + 2) * kstep; \
            const char* a3 = a2 + kstep; const char* b3 = b2 + kstep; \
            PG8_LDB(B0, 0, 0); PG8_LDB(B1, 0, 1); PG8_SCHED; PG8_LDA(At, 0, 0); PG8_STAGE(PG8_SA(1, 1), a1 + hstep, voffA); \
            PG8_WAIT_V(8); PG8_WAIT_L(0); PG8_BAR; MMA(0, 0, At, B0); MMA(0, 1, At, B1); PG8_BAR; PG8_SCHED; \
            PG8_LDA(At, 0, 1); PG8_STAGE(PG8_SB(0, 0), b2, voffB); PG8_STAGE(PG8_SB(0, 1), b2 + hstep, voffB); PG8_STAGE(PG8_SA(0, 0), a2, voffA); \
            PG8_WAIT_V(8); PG8_WAIT_L(0); PG8_BAR; MMA(1, 0, At, B0); MMA(1, 1, At, B1); PG8_BAR; PG8_SCHED; \
            PG8_LDB(B0, 1, 0); PG8_LDB(B1, 1, 1); PG8_SCHED; PG8_LDA(At, 1, 0); PG8_STAGE(PG8_SA(0, 1), a2 + hstep, voffA); \
            PG8_WAIT_V(8); PG8_WAIT_L(0); PG8_BAR; MMA(0, 0, At, B0); MMA(0, 1, At, B1); PG8_BAR; PG8_SCHED; \
            PG8_LDA(At, 1, 1); PG8_STAGE(PG8_SB(1, 0), b3, voffB); PG8_STAGE(PG8_SB(1, 1), b3 + hstep, voffB); PG8_STAGE(PG8_SA(1, 0), a3, voffA); \
            PG8_WAIT_V(8); PG8_WAIT_L(0); PG8_BAR; MMA(1, 0, At, B0); MMA(1, 1, At, B1); PG8_BAR; PG8_SCHED; }
    Unit cur, nxt; int ui = 0;
    if (!S.next(0, cur)) return;
    f32x4 acc[2][2][4][2];
#pragma unroll
    for (int a = 0; a < 2; ++a)
#pragma unroll
        for (int b = 0; b < 2; ++b)
#pragma unroll
            for (int m = 0; m < 4; ++m)
#pragma unroll
                for (int n = 0; n < 2; ++n) acc[a][b][m][n] = (f32x4){0.f, 0.f, 0.f, 0.f};
    i32x8 At[4], B0[2], B1[2];
    const int sc1 = 0x7f7f7f7f;
    const char* cA = cur.a; const char* cB = cur.b;
    {
        PG8_STAGE(PG8_SB(0, 0), cB, voffB); PG8_STAGE(PG8_SB(0, 1), cB + hstep, voffB); PG8_STAGE(PG8_SA(0, 0), cA, voffA); PG8_STAGE(PG8_SA(0, 1), cA + hstep, voffA);
        if (wr == 1) PG8_BAR;
        PG8_WAIT_V(2); PG8_BAR;
        PG8_STAGE(PG8_SB(1, 0), cB + kstep, voffB); PG8_STAGE(PG8_SA(1, 0), cA + kstep, voffA); PG8_STAGE(PG8_SB(1, 1), cB + hstep + kstep, voffB);
        PG8_WAIT_V(6); PG8_BAR;
    }
    for (;;) {
        const bool has_next = S.next(ui + 1, nxt);
        const char* nA = has_next ? nxt.a : cA; const char* nB = has_next ? nxt.b : cB;
        const int nt = cur.nt;
        if constexpr (F8) { PG8_KLOOP(PG8_MMA8) asm volatile("s_nop 15\n\ts_nop 15" ::: "memory"); } else { PG8_KLOOP(PG8_MMA16) }
        if (wr == 0) PG8_BAR;
        E(acc, cur, wr, wc, fr, fq);
        if (!has_next) break;
        if (!(Epi::CARRY && cur.seg < 3)) {
#pragma unroll
            for (int a = 0; a < 2; ++a)
#pragma unroll
                for (int b = 0; b < 2; ++b)
#pragma unroll
                    for (int m = 0; m < 4; ++m)
#pragma unroll
                        for (int n = 0; n < 2; ++n) acc[a][b][m][n] = (f32x4){0.f, 0.f, 0.f, 0.f}; }
        cur = nxt; cA = nA; cB = nB; ++ui;
        if (wr == 1) PG8_BAR;
    }
    PG8_WAIT_V(0);
    PG8_BAR;
#undef PG8_SA
#undef PG8_SB
#undef PG8_STAGE
#undef PG8_LDA
#undef PG8_LDB
#undef PG8_MMA16
#undef PG8_MMA8
#undef PG8_LD8
#undef PG8_LO
#undef PG8_HI
#undef PG8_KLOOP
#undef PG8_WAIT_V
#undef PG8_WAIT_L
#undef PG8_BAR
#undef PG8_SCHED
}

struct SchedG {
    const char* A; const char* B; int rowB, nM, nN, nt, G, c, nExtra, exPm0, exPn0, exNm, pn0;
    __device__ __forceinline__ bool next(int i, Unit& u) const {
        const int L = i * G + c, nwg = nM * nN;
        if (L < nwg) tile_of(L, nM, nN, u.pm, u.pn);
        else if (L < nwg + nExtra) { const int idx = L - nwg; u.pm = exPm0 + idx % exNm; u.pn = exPn0 + idx / exNm; }
        else return false;
        u.seg = 0; u.f8 = 0; u.nt = nt; u.a = A + (size_t)u.pm * 256 * rowB; u.b = B + (size_t)u.pn * 256 * rowB; u.pn += pn0; return true;
    }
};
struct SchedSeg {
    const char* A; const char* B; int ld, nM, nN, G, c;
    __device__ __forceinline__ bool next(int i, Unit& u) const {
        const int L = (i >> 2) * G + c; if (L >= nM * nN) return false;
        tile_of(L, nM, nN, u.pm, u.pn);
        const int s = i & 3; u.seg = s; u.f8 = 0; u.nt = s == 0 ? 16 : 8; const int koff = s == 0 ? 0 : 512 + 512 * s;
        u.a = A + ((size_t)u.pm * 256 * ld + koff) * 2; u.b = B + ((size_t)u.pn * 256 * ld + koff) * 2; return true;
    }
};

struct EpiP {
    static constexpr bool PERM = true, CARRY = false;
    bf16_t* P;
    __device__ __forceinline__ void operator()(const f32x4 (&acc)[2][2][4][2], const Unit& u, int wr, int wc, int fr, int fq) const {
        const int row0 = u.pm * 256 + wr * 64 + fr; const int colt = u.pn * 256 + wc * 32 + 8 * fq;
#pragma unroll
        for (int ai = 0; ai < 2; ++ai)
#pragma unroll
            for (int m = 0; m < 4; ++m) { bf16_t* rowp = P + (size_t)(row0 + ai * 128 + m * 16) * INW + colt;
#pragma unroll
                for (int bj = 0; bj < 2; ++bj) { const f32x4 v0 = acc[ai][bj][m][0], v1 = acc[ai][bj][m][1];
                    u32x4 w; w.x = cvt_pk_bf16(v0[0], v0[1]); w.y = cvt_pk_bf16(v0[2], v0[3]); w.z = cvt_pk_bf16(v1[0], v1[1]); w.w = cvt_pk_bf16(v1[2], v1[3]);
                    *(u32x4*)(rowp + bj * 128) = w; } }
    }
};
struct EpiG {
    static constexpr bool PERM = true, CARRY = false;
    bf16_t* Gt; const float* bg;
    __device__ __forceinline__ void operator()(const f32x4 (&acc)[2][2][4][2], const Unit& u, int wr, int wc, int fr, int fq) const {
        const int t512 = (wr * 4 + wc) * 64 + fq * 16 + fr;
        const int gc = (u.pn - 18) * 256 + wc * 32 + 8 * fq;
        f32x4 bv[2][2];
#pragma unroll
        for (int bj = 0; bj < 2; ++bj)
#pragma unroll
            for (int n = 0; n < 2; ++n) bv[bj][n] = *(const f32x4*)(bg + gc + bj * 128 + 4 * n);
        u32x4* gdst = (u32x4*)Gt + (size_t)(u.pm * 32 + (u.pn - 18)) * 8192 + t512;
        constexpr float SC = 1.f / WG8_SCALE;
#pragma unroll
        for (int ai = 0; ai < 2; ++ai)
#pragma unroll
            for (int m = 0; m < 4; ++m) {
#pragma unroll
                for (int bj = 0; bj < 2; ++bj) { const f32x4 v0 = acc[ai][bj][m][0] * SC + bv[bj][0], v1 = acc[ai][bj][m][1] * SC + bv[bj][1];
                    u32x4 w; w.x = cvt_pk_bf16(v0[0], v0[1]); w.y = cvt_pk_bf16(v0[2], v0[3]); w.z = cvt_pk_bf16(v1[0], v1[1]); w.w = cvt_pk_bf16(v1[2], v1[3]);
                    __builtin_nontemporal_store(w, &gdst[((ai * 4 + m) * 2 + bj) * 512]); } }
    }
};
struct EpiB {
    static constexpr bool PERM = true, CARRY = true;
    bf16_t* MG; const bf16_t* Gt;
    __device__ __forceinline__ void operator()(f32x4 (&acc)[2][2][4][2], const Unit& u, int wr, int wc, int fr, int fq) const {
        const int row0 = u.pm * 256 + wr * 64 + fr; const int colt = u.pn * 256 + wc * 32 + 8 * fq; const int seg = u.seg;
        const int t512 = (wr * 4 + wc) * 64 + fq * 16 + fr;
        const u32x4* gsrc = (const u32x4*)Gt + (size_t)(u.pm * 32 + seg * 8 + u.pn) * 8192 + t512;
        const u32x4* gnxt = gsrc + (size_t)8 * 8192;
#pragma unroll
        for (int ai = 0; ai < 2; ++ai) {
            u32x4 gw[8], gn[8];
#pragma unroll
            for (int j = 0; j < 8; ++j) gw[j] = __builtin_nontemporal_load(&gsrc[(ai * 8 + j) * 512]);
            if (seg < 3) {
#pragma unroll
                for (int j = 0; j < 8; ++j) gn[j] = __builtin_nontemporal_load(&gnxt[(ai * 8 + j) * 512]); }
#pragma unroll
            for (int m = 0; m < 4; ++m) { const size_t row = (size_t)(row0 + ai * 128 + m * 16);
#pragma unroll
                for (int bj = 0; bj < 2; ++bj) { const int j = m * 2 + bj;
                    const f32x4 a0 = acc[ai][bj][m][0], a1 = acc[ai][bj][m][1];
                    float v0 = a0[0] * sigmoidf_(bflo(gw[j].x)), v1 = a0[1] * sigmoidf_(bfhi(gw[j].x)), v2 = a0[2] * sigmoidf_(bflo(gw[j].y)), v3 = a0[3] * sigmoidf_(bfhi(gw[j].y));
                    float v4 = a1[0] * sigmoidf_(bflo(gw[j].z)), v5 = a1[1] * sigmoidf_(bfhi(gw[j].z)), v6 = a1[2] * sigmoidf_(bflo(gw[j].w)), v7 = a1[3] * sigmoidf_(bfhi(gw[j].w));
                    if (seg < 3) {
#define INVG(x) (1.f + __builtin_amdgcn_exp2f(-1.4426950408889634f * (x)))
                        acc[ai][bj][m][0] = (f32x4){v0 * INVG(bflo(gn[j].x)), v1 * INVG(bfhi(gn[j].x)), v2 * INVG(bflo(gn[j].y)), v3 * INVG(bfhi(gn[j].y))};
                        acc[ai][bj][m][1] = (f32x4){v4 * INVG(bflo(gn[j].z)), v5 * INVG(bfhi(gn[j].z)), v6 * INVG(bflo(gn[j].w)), v7 * INVG(bfhi(gn[j].w))};
#undef INVG
                    } else {
                        u32x4 w; w.x = cvt_pk_bf16(v0, v1); w.y = cvt_pk_bf16(v2, v3); w.z = cvt_pk_bf16(v4, v5); w.w = cvt_pk_bf16(v6, v7);
                        *(u32x4*)(MG + row * DM + colt + bj * 128) = w; } } }
        }
    }
};
struct EpiRaw {
    static constexpr bool PERM = true, CARRY = false;
    bf16_t* O; int ldc;
    __device__ __forceinline__ void operator()(const f32x4 (&acc)[2][2][4][2], const Unit& u, int wr, int wc, int fr, int fq) const {
        const int row0 = u.pm * 256 + wr * 64 + fr; const int colt = u.pn * 256 + wc * 32 + 8 * fq;
#pragma unroll
        for (int ai = 0; ai < 2; ++ai)
#pragma unroll
            for (int m = 0; m < 4; ++m) { bf16_t* rowp = O + (size_t)(row0 + ai * 128 + m * 16) * ldc + colt;
#pragma unroll
                for (int bj = 0; bj < 2; ++bj) { const f32x4 v0 = acc[ai][bj][m][0], v1 = acc[ai][bj][m][1];
                    u32x4 w; w.x = cvt_pk_bf16(v0[0], v0[1]); w.y = cvt_pk_bf16(v0[2], v0[3]); w.z = cvt_pk_bf16(v1[0], v1[1]); w.w = cvt_pk_bf16(v1[2], v1[3]);
                    __builtin_nontemporal_store(w, (u32x4*)(rowp + bj * 128)); } }
    }
};
struct EpiSwiglu {
    static constexpr bool PERM = true, CARRY = false;
    bf16_t* ACT;
    __device__ __forceinline__ void operator()(const f32x4 (&acc)[2][2][4][2], const Unit& u, int wr, int wc, int fr, int fq) const {
        const int row0 = u.pm * 256 + wr * 64 + fr; const int colt = u.pn * 128 + wc * 32 + 8 * fq;
#pragma unroll
        for (int ai = 0; ai < 2; ++ai)
#pragma unroll
            for (int m = 0; m < 4; ++m) { const f32x4 g0 = acc[ai][0][m][0], g1 = acc[ai][0][m][1], u0 = acc[ai][1][m][0], u1 = acc[ai][1][m][1];
                u32x4 w;
                w.x = cvt_pk_bf16(g0[0] * sigmoidf_(g0[0]) * u0[0], g0[1] * sigmoidf_(g0[1]) * u0[1]);
                w.y = cvt_pk_bf16(g0[2] * sigmoidf_(g0[2]) * u0[2], g0[3] * sigmoidf_(g0[3]) * u0[3]);
                w.z = cvt_pk_bf16(g1[0] * sigmoidf_(g1[0]) * u1[0], g1[1] * sigmoidf_(g1[1]) * u1[1]);
                w.w = cvt_pk_bf16(g1[2] * sigmoidf_(g1[2]) * u1[2], g1[3] * sigmoidf_(g1[3]) * u1[3]);
                *(u32x4*)(ACT + (size_t)(row0 + ai * 128 + m * 16) * DFF + colt) = w; }
    }
};
}

namespace att {
constexpr int D = 128, NW = 8, QBLK = 32, KVBLK = 64;
constexpr float SCALE = 0.088388347648318440f;
constexpr float THR = 8.f;
constexpr int LDQ = 1024, LDK = 256, LDO = BRK;
constexpr size_t SHM_V = KVBLK * D * 2, SHM_K = KVBLK * D * 2, SHM_ATTN = 2 * SHM_V + 2 * SHM_K + NW * 64 * 4;
#define KSWZ(row, colB) ((row) * 256 + ((colB) ^ (((row) & 7) << 4)))
#define SBAR() __builtin_amdgcn_sched_barrier(0)
__device__ __forceinline__ int crow(int r, int hi) { return (r & 3) + 8 * (r >> 2) + 4 * hi; }
__device__ __forceinline__ void partialSM(f32x16& p0, f32x16& p1, float& m_reg, float& mn, float& alpha) {
  constexpr float C = SCALE * 1.4426950408889634f;
  float pmax = p0[0]; for (int r = 1; r < 16; ++r) pmax = fmaxf(pmax, p0[r]); for (int r = 0; r < 16; ++r) pmax = fmaxf(pmax, p1[r]);
  { auto rr = __builtin_amdgcn_permlane32_swap(__float_as_uint(pmax), __float_as_uint(pmax), false, false);
    pmax = fmaxf(__uint_as_float(rr[0]), __uint_as_float(rr[1])); }
  if (__builtin_expect(__all(pmax - m_reg <= THR / SCALE), 1)) { mn = m_reg; alpha = 1.f; }
  else { mn = fmaxf(m_reg, pmax); alpha = __builtin_amdgcn_exp2f((m_reg - mn) * C); m_reg = mn; }
  float mnC = -mn * C;
  for (int r = 0; r < 16; ++r) p0[r] = fmaf(p0[r], C, mnC); for (int r = 0; r < 16; ++r) p1[r] = fmaf(p1[r], C, mnC);
  for (int r = 0; r < 16; ++r) p0[r] = __builtin_amdgcn_exp2f(p0[r]);
}
__device__ __forceinline__ void finishSM(f32x16& p0, f32x16& p1, float alpha, float& l_reg, bf16x8& pa0, bf16x8& pa1, bf16x8& pa2, bf16x8& pa3) {
  for (int r = 0; r < 16; ++r) p1[r] = __builtin_amdgcn_exp2f(p1[r]);
  float ps = 0; for (int r = 0; r < 16; ++r) ps += p0[r]; for (int r = 0; r < 16; ++r) ps += p1[r];
  { auto rr = __builtin_amdgcn_permlane32_swap(__float_as_uint(ps), __float_as_uint(ps), false, false);
    ps = __uint_as_float(rr[0]) + __uint_as_float(rr[1]); }
  l_reg = l_reg * alpha + ps;
#define PK4(P, BASE, OUT) do { unsigned a0 = cvt_pk_bf16(P[BASE + 0], P[BASE + 1]), a1 = cvt_pk_bf16(P[BASE + 2], P[BASE + 3]);   \
    unsigned b0 = cvt_pk_bf16(P[BASE + 4], P[BASE + 5]), b1 = cvt_pk_bf16(P[BASE + 6], P[BASE + 7]);                              \
    auto r0 = __builtin_amdgcn_permlane32_swap(a0, b0, false, false); auto r1 = __builtin_amdgcn_permlane32_swap(a1, b1, false, false); \
    u32x4 w = {r0[0], r1[0], r0[1], r1[1]}; OUT = *reinterpret_cast<bf16x8*>(&w); } while (0)
  PK4(p0, 0, pa0); PK4(p0, 8, pa1); PK4(p1, 0, pa2); PK4(p1, 8, pa3);
#undef PK4
}
__device__ __forceinline__ void qkt(f32x16& p0, f32x16& p1, const bf16_t* Ks, const bf16x8* qr, int r32, int hi) {
  p0 = f32x16{}; p1 = f32x16{};
  for (int d0 = 0; d0 < 8; ++d0) { int cb = (d0 * 16 + hi * 8) * 2;
    bf16x8 b0 = *reinterpret_cast<const bf16x8*>((const char*)Ks + KSWZ(r32, cb));
    bf16x8 b1 = *reinterpret_cast<const bf16x8*>((const char*)Ks + KSWZ(32 + r32, cb));
    p0 = __builtin_amdgcn_mfma_f32_32x32x16_bf16(b0, qr[d0], p0, 0, 0, 0);
    p1 = __builtin_amdgcn_mfma_f32_32x32x16_bf16(b1, qr[d0], p1, 0, 0, 0); }
}
__device__ __forceinline__ int v_st(int k, int c) { const int kk = (k & ~0xC) | ((k & 4) << 1) | ((k & 8) >> 1); return ((kk >> 3) * 4 + (c >> 5)) * 512 + ((kk & 7) * 32 + (c & 31)) * 2; }
__device__ __forceinline__ int v_rd_base(int lane) { return ((lane & 3) << 3) | (((lane >> 2) & 3) << 6) | (((lane >> 4) & 1) << 5) | (((lane >> 5) & 1) << 8); }
constexpr int v_rd_off(int d0, int ks, int half) { return d0 * 512 + ks * 4096 + half * 2048; }
template <int OFF> __device__ __forceinline__ s16x4 tr_read(int vb) {
  s16x4 r; asm volatile("ds_read_b64_tr_b16 %0, %1 offset:%2" : "=&v"(r) : "v"(vb), "i"(OFF) : "memory"); return r;
}
template <int D0> __device__ __forceinline__ void pv_one(f32x16& od, int vb, bf16x8 pa0, bf16x8 pa1, bf16x8 pa2, bf16x8 pa3) {
  const s16x4 l0 = tr_read<v_rd_off(D0, 0, 0)>(vb), h0 = tr_read<v_rd_off(D0, 0, 1)>(vb), l1 = tr_read<v_rd_off(D0, 1, 0)>(vb), h1 = tr_read<v_rd_off(D0, 1, 1)>(vb);
  const s16x4 l2 = tr_read<v_rd_off(D0, 2, 0)>(vb), h2 = tr_read<v_rd_off(D0, 2, 1)>(vb), l3 = tr_read<v_rd_off(D0, 3, 0)>(vb), h3 = tr_read<v_rd_off(D0, 3, 1)>(vb);
  asm volatile("s_waitcnt lgkmcnt(0)" ::: "memory"); SBAR();
#define PK(L, H) (bf16x8){L[0], L[1], L[2], L[3], H[0], H[1], H[2], H[3]}
  od = __builtin_amdgcn_mfma_f32_32x32x16_bf16(pa0, PK(l0, h0), od, 0, 0, 0);
  od = __builtin_amdgcn_mfma_f32_32x32x16_bf16(pa1, PK(l1, h1), od, 0, 0, 0);
  od = __builtin_amdgcn_mfma_f32_32x32x16_bf16(pa2, PK(l2, h2), od, 0, 0, 0);
  od = __builtin_amdgcn_mfma_f32_32x32x16_bf16(pa3, PK(l3, h3), od, 0, 0, 0);
#undef PK
}
__device__ __forceinline__ void pv_d0(f32x16* o, int vb, bf16x8 pa0, bf16x8 pa1, bf16x8 pa2, bf16x8 pa3) {
  pv_one<0>(o[0], vb, pa0, pa1, pa2, pa3); pv_one<1>(o[1], vb, pa0, pa1, pa2, pa3); pv_one<2>(o[2], vb, pa0, pa1, pa2, pa3); pv_one<3>(o[3], vb, pa0, pa1, pa2, pa3);
}
__device__ __forceinline__ void attn_dense_body(const bf16_t* __restrict__ Qb, const bf16_t* __restrict__ Kh, const bf16_t* __restrict__ Vh,
                                                bf16_t* __restrict__ Ob, int seq, char* lds) {
  constexpr int SDEPTH = 2;
  const int tid = opaque_tid(), wid = tid >> 6, lane = tid & 63, r32 = lane & 31, hi = lane >> 5;
  bf16_t* V_lds = (bf16_t*)lds; bf16_t* K_lds = (bf16_t*)(lds + 2 * SHM_V);
  float* ws = (float*)(lds + 2 * SHM_V + 2 * SHM_K) + wid * 64; float* li_l = ws; float* al_l = ws + 32;
  float m_reg = -1e30f, l_reg = 0; f32x16 o[4] = {}; bf16x8 qr[8];
  const bf16_t* Qw = Qb + (long)(wid * QBLK + r32) * LDQ + hi * 8;
#pragma unroll
  for (int d0 = 0; d0 < 8; ++d0) qr[d0] = *reinterpret_cast<const bf16x8*>(Qw + d0 * 16);
  const int sr = tid >> 4, sc = (tid & 15) * 8, vst0 = v_st(sr, sc), vst1 = v_st(32 + sr, sc);
  const int vb0 = (int)(uintptr_t)V_lds + v_rd_base(lane);
  struct { bf16x8 vs0, vs1, ks0, ks1; } sr_[SDEPTH];
#define SLOAD(i, k0) do { sr_[i].vs0 = *reinterpret_cast<const bf16x8*>(&Vh[(long)((k0) + sr) * LDK + sc]); sr_[i].vs1 = *reinterpret_cast<const bf16x8*>(&Vh[(long)((k0) + 32 + sr) * LDK + sc]); \
    sr_[i].ks0 = *reinterpret_cast<const bf16x8*>(&Kh[(long)((k0) + sr) * LDK + sc]); sr_[i].ks1 = *reinterpret_cast<const bf16x8*>(&Kh[(long)((k0) + 32 + sr) * LDK + sc]); } while (0)
#define SWRITE(b, i) do { *(bf16x8*)((char*)V_lds + (b) * SHM_V + vst0) = sr_[i].vs0;          \
    *(bf16x8*)((char*)V_lds + (b) * SHM_V + vst1) = sr_[i].vs1; int kc = sc * 2;               \
    *(bf16x8*)((char*)K_lds + (b) * SHM_K + KSWZ(sr, kc)) = sr_[i].ks0;                       \
    *(bf16x8*)((char*)K_lds + (b) * SHM_K + KSWZ(32 + sr, kc)) = sr_[i].ks1; } while (0)
#define SWAIT() do { asm volatile("s_waitcnt vmcnt(4)" ::: "memory"); } while (0)
#define RESC(a) do { if (__any((a) < 1.f)) { if (hi == 0) al_l[r32] = (a); asm volatile("s_waitcnt lgkmcnt(0)" ::: "memory"); \
    for (int d = 0; d < 4; ++d) for (int r = 0; r < 16; ++r) o[d][r] *= al_l[crow(r, hi)]; } } while (0)
  f32x16 pA0, pA1, pB0, pB1; float mnA, mnB, alA, alB; bf16x8 pa0, pa1, pa2, pa3; const int NT = seq / KVBLK;
  constexpr int SE = 0, SO = SDEPTH - 1;
  SLOAD(SE, 0); asm volatile("s_waitcnt vmcnt(0)" ::: "memory"); SWRITE(0, SE); __syncthreads();
  qkt(pA0, pA1, K_lds, qr, r32, hi); partialSM(pA0, pA1, m_reg, mnA, alA);
  SLOAD(SO, KVBLK); if (2 < NT) SLOAD(SE, 2 * KVBLK);
  SWAIT(); SWRITE(1, SO); __syncthreads();
  for (int j = 1; j + 1 < NT; j += 2) {
    SBAR(); qkt(pB0, pB1, (bf16_t*)((char*)K_lds + SHM_K), qr, r32, hi);
    finishSM(pA0, pA1, alA, l_reg, pa0, pa1, pa2, pa3); SBAR();
    SLOAD(SO, (j + SDEPTH) * KVBLK); SBAR();
    pv_d0(o, vb0, pa0, pa1, pa2, pa3); partialSM(pB0, pB1, m_reg, mnB, alB);
    __syncthreads(); SWAIT(); SWRITE(0, SE);
    RESC(alB); __syncthreads();
    SBAR(); qkt(pA0, pA1, K_lds, qr, r32, hi);
    finishSM(pB0, pB1, alB, l_reg, pa0, pa1, pa2, pa3); SBAR();
    if (j + 3 < NT) SLOAD(SE, (j + 1 + SDEPTH) * KVBLK); SBAR();
    pv_d0(o, vb0 + (int)SHM_V, pa0, pa1, pa2, pa3); partialSM(pA0, pA1, m_reg, mnA, alA);
    __syncthreads(); SWAIT(); SWRITE(1, SO);
    RESC(alA); __syncthreads();
  }
  SBAR(); qkt(pB0, pB1, (bf16_t*)((char*)K_lds + SHM_K), qr, r32, hi);
  finishSM(pA0, pA1, alA, l_reg, pa0, pa1, pa2, pa3); SBAR();
  pv_d0(o, vb0, pa0, pa1, pa2, pa3); partialSM(pB0, pB1, m_reg, mnB, alB);
  __syncthreads(); RESC(alB);
  finishSM(pB0, pB1, alB, l_reg, pa0, pa1, pa2, pa3); SBAR();
  pv_d0(o, vb0 + (int)SHM_V, pa0, pa1, pa2, pa3);
  if (hi == 0) li_l[r32] = l_reg; asm volatile("s_waitcnt lgkmcnt(0)" ::: "memory");
  float rli[16];
#pragma unroll
  for (int r = 0; r < 16; ++r) rli[r] = __builtin_amdgcn_rcpf(li_l[crow(r, hi)]);
  bf16_t* Ow = Ob + (long)(wid * QBLK) * LDO;
#pragma unroll
  for (int r = 0; r < 16; ++r) { int orow = crow(r, hi);
    for (int d0 = 0; d0 < 4; ++d0) Ow[(long)orow * LDO + d0 * 32 + r32] = f2bf(o[d0][r] * rli[r]); }
  asm volatile("s_waitcnt vmcnt(0) lgkmcnt(0)" ::: "memory");
  __syncthreads();
#undef SLOAD
#undef SWRITE
#undef SWAIT
#undef RESC
}
#undef KSWZ
#undef SBAR
}

#define XB_TMO      128
#define XB_XCNT(j)  (256  + 64 * (j))
#define XB_XSUB(j)  (1280 + 64 * (j))
#define XB_XGEN(j)  (2304 + 64 * (j))
#define XB_TOP      3328
#define XB_TOPGEN   3392
#define XCD_BAR_WORDS 3456
#define XB_SPIN_CAP (1u << 18)
__device__ __forceinline__ unsigned xb_ld(unsigned* p)              { return __hip_atomic_load(p, __ATOMIC_RELAXED, __HIP_MEMORY_SCOPE_AGENT); }
__device__ __forceinline__ unsigned xb_add(unsigned* p, unsigned v) { return __hip_atomic_fetch_add(p, v, __ATOMIC_RELAXED, __HIP_MEMORY_SCOPE_AGENT); }
__device__ __forceinline__ unsigned xb_xcc_id() { return (unsigned)__builtin_amdgcn_s_getreg((3 << 11) | 20) & 0xFu; }
#define XB_SPIN(cond, bar) do { unsigned _sp = 0; while (cond) { __builtin_amdgcn_s_sleep(1); \
    if ((++_sp & 255u) == 0u) { if (xb_ld(&(bar)[XB_TMO])) break; if (_sp > XB_SPIN_CAP) { atomicAdd(&(bar)[XB_TMO], 1u); break; } } } } while (0)
struct XcdBarrier { unsigned* bar; unsigned x; volatile LAS unsigned* st; };
__device__ __forceinline__ XcdBarrier xcd_barrier_post(unsigned* bar, volatile LAS unsigned* st) {
    XcdBarrier b; b.bar = bar; b.x = xb_xcc_id(); b.st = st;
    if (threadIdx.x == 0) (void)xb_add(&bar[XB_XCNT(b.x)], 1u);
    return b;
}
__device__ __forceinline__ void xcd_barrier_complete(unsigned* bar, unsigned x, unsigned& nloc, unsigned& nx) {
    const unsigned G = gridDim.x * gridDim.y * gridDim.z;
    unsigned sum, cnt, mine, sp = 0u;
    for (;;) {
        sum = 0u; cnt = 0u; mine = 0u;
#pragma unroll
        for (unsigned j = 0; j < 16; ++j) { const unsigned c = xb_ld(&bar[XB_XCNT(j)]); sum += c; cnt += (c > 0u) ? 1u : 0u; mine = (j == x) ? c : mine; }
        if (sum == G) break;
        __builtin_amdgcn_s_sleep(1);
        if ((++sp & 255u) == 0u) { if (xb_ld(&bar[XB_TMO])) break; if (sp > XB_SPIN_CAP) { atomicAdd(&bar[XB_TMO], 1u); break; } }
    }
    nloc = mine > 0u ? mine : 1u; nx = cnt > 0u ? cnt : 1u;
}
__device__ __forceinline__ void xcd_barrier(const XcdBarrier& b) {
    asm volatile("s_waitcnt vmcnt(0)" ::: "memory");
    __syncthreads();
    if (threadIdx.x == 0) {
        unsigned* bar = b.bar;
        __builtin_amdgcn_s_waitcnt(0);
        unsigned nloc = b.st[0], nx = b.st[1];
        if (nloc == 0u) { xcd_barrier_complete(bar, b.x, nloc, nx); b.st[0] = nloc; b.st[1] = nx; }
        const unsigned old = xb_add(&bar[XB_XSUB(b.x)], 1u);
        const unsigned gen = old / nloc;
        if (old + 1u == (gen + 1u) * nloc) {
            __builtin_amdgcn_fence(__ATOMIC_RELEASE, "agent");
            asm volatile("s_waitcnt vmcnt(0)" ::: "memory");
            const unsigned og = xb_add(&bar[XB_TOP], 1u);
            const unsigned tg = og / nx;
            if (og + 1u == (tg + 1u) * nx) xb_add(&bar[XB_TOPGEN], 1u);
            else XB_SPIN(xb_ld(&bar[XB_TOPGEN]) == tg, bar);
            __builtin_amdgcn_fence(__ATOMIC_ACQUIRE, "agent");
            xb_add(&bar[XB_XGEN(b.x)], 1u);
            asm volatile("s_waitcnt vmcnt(0)" ::: "memory");
        } else {
            XB_SPIN(xb_ld(&bar[XB_XGEN(b.x)]) == gen, bar);
            __builtin_amdgcn_fence(__ATOMIC_ACQUIRE, "agent");
            asm volatile("s_waitcnt vmcnt(0)" ::: "memory");
        }
    }
    __syncthreads();
}

struct Args { const float* in[30]; float* out; unsigned char* ws; int ph_lo, ph_hi; };
enum { I_X = 0, I_C, I_CTX, I_CCTX, I_WADA, I_BADA, I_WIN, I_QG, I_KG, I_POOLW, I_POOLS, I_SLNG, I_SLNB, I_SGUW, I_SGUB, I_CONVW,
       I_WBRA, I_WBRP, I_WBRS, I_WBRC, I_WGATE, I_BGATE, I_WO, I_LN1G, I_LN1B, I_WFG, I_WFU, I_WFD, I_LN2G, I_LN2B };

__device__ __forceinline__ void phase_mods(const Args& a, char* lds, int l_lo, int l_hi, int wg, int nwg, bool do_rope) {
    const int tid = opaque_tid();
    float* sc = (float*)lds;
    float* red = (float*)(lds + 9 * 2048 * 4);
    for (int i = tid; i < 9 * 2048; i += 512) { const int r = i >> 11, k = i & 2047; const float v = r < 8 ? a.in[I_C][r * 2048 + k] : a.in[I_CCTX][k]; sc[i] = v * sigmoidf_(v); }
    __syncthreads();
    float* mod = (float*)(a.ws + WS_MOD);
    const int lane = tid & 63, wave = tid >> 6, c4 = (lane & 15) * 4, kr = lane >> 4;
    for (int it = wg; it < (l_hi - l_lo) * (MODW / 64); it += nwg) {
        const int l = l_lo + it / (MODW / 64), n0 = (it % (MODW / 64)) * 64;
        const float* W = a.in[I_WADA] + (size_t)l * DM * MODW + n0 + c4;
        f32x4 acc[9];
#pragma unroll
        for (int r = 0; r < 9; ++r) acc[r] = (f32x4){0.f, 0.f, 0.f, 0.f};
#pragma unroll 8
        for (int i = 0; i < 64; ++i) { const int k = wave * 256 + i * 4 + kr; const f32x4 w = __builtin_nontemporal_load((const f32x4*)(W + (size_t)k * MODW));
#pragma unroll
            for (int r = 0; r < 9; ++r) acc[r] += w * sc[r * 2048 + k]; }
#pragma unroll
        for (int r = 0; r < 9; ++r)
#pragma unroll
            for (int e = 0; e < 4; ++e) { float v = acc[r][e]; v += __shfl_xor(v, 16); v += __shfl_xor(v, 32); acc[r][e] = v; }
        if (kr == 0) {
#pragma unroll
            for (int r = 0; r < 9; ++r) *(f32x4*)(red + (wave * 9 + r) * 64 + c4) = acc[r]; }
        __syncthreads();
        for (int i = tid; i < 9 * 64; i += 512) { const int r = i >> 6, cc = i & 63; float sm = 0.f;
#pragma unroll
            for (int g = 0; g < 8; ++g) sm += red[(g * 9 + r) * 64 + cc];
            mod[((size_t)l * 9 + r) * MODW + n0 + cc] = sm + a.in[I_BADA][l * MODW + n0 + cc]; }
        __syncthreads();
    }
    if (do_rope) {
        float* rope = (float*)(a.ws + WS_ROPE);
        for (int i = tid; i < 64 * 32; i += 512) { const int pos = i >> 5, j = i & 31;
            const float inv = exp2f(-(float)(2 * j) / 64.f * 13.287712379549449f);
            const float ang = (float)pos * inv; const float turns = ang * 0.15915494309189535f; const float fr = turns - floorf(turns);
            rope[2 * i] = __builtin_amdgcn_cosf(fr); rope[2 * i + 1] = __builtin_amdgcn_sinf(fr); }
    }
}

__device__ __forceinline__ void tr_item(const float* W, int N, bf16_t* WT, int ldd, int drow0, int dk0, int k0, int n0, float* scr, int lane) {
    { const int r = lane >> 3, c4 = (lane & 7) * 4; f32x4 v[8];
#pragma unroll
        for (int i = 0; i < 8; ++i) v[i] = __builtin_nontemporal_load((const f32x4*)(W + (size_t)(k0 + r + 8 * i) * N + n0 + c4));
#pragma unroll
        for (int i = 0; i < 8; ++i) { float* d = scr + (r + 8 * i) * 33 + c4; d[0] = v[i][0]; d[1] = v[i][1]; d[2] = v[i][2]; d[3] = v[i][3]; } }
    LDS_WAIT(); asm volatile("" ::: "memory");
    const int c = lane & 7;
#pragma unroll
    for (int j = 0; j < 4; ++j) { const int n = (lane >> 3) + 8 * j; const float* s = scr + (8 * c) * 33 + n;
        u32x4 o; o.x = cvt_pk_bf16(s[0 * 33], s[1 * 33]); o.y = cvt_pk_bf16(s[2 * 33], s[3 * 33]); o.z = cvt_pk_bf16(s[4 * 33], s[5 * 33]); o.w = cvt_pk_bf16(s[6 * 33], s[7 * 33]);
        *(u32x4*)(WT + (size_t)(drow0 + n0 + n) * ldd + dk0 + k0 + 8 * c) = o; }
    LDS_WAIT(); asm volatile("" ::: "memory");
}
__device__ __forceinline__ void tr_item8(const float* W, int N, unsigned char* WT, int k0, int n0, float* scr, int lane) {
    { const int r = lane >> 3, c4 = (lane & 7) * 4; f32x4 v[8];
#pragma unroll
        for (int i = 0; i < 8; ++i) v[i] = __builtin_nontemporal_load((const f32x4*)(W + (size_t)(k0 + r + 8 * i) * N + n0 + c4));
#pragma unroll
        for (int i = 0; i < 8; ++i) { float* d = scr + (r + 8 * i) * 33 + c4; d[0] = v[i][0]; d[1] = v[i][1]; d[2] = v[i][2]; d[3] = v[i][3]; } }
    LDS_WAIT(); asm volatile("" ::: "memory");
    const int c = lane & 7;
#pragma unroll
    for (int j = 0; j < 4; ++j) { const int n = (lane >> 3) + 8 * j; const float* sp = scr + (8 * c) * 33 + n;
        unsigned lo = 0, hi = 0;
        lo = __builtin_amdgcn_cvt_pk_fp8_f32(sp[0 * 33] * WG8_SCALE, sp[1 * 33] * WG8_SCALE, lo, false); lo = __builtin_amdgcn_cvt_pk_fp8_f32(sp[2 * 33] * WG8_SCALE, sp[3 * 33] * WG8_SCALE, lo, true);
        hi = __builtin_amdgcn_cvt_pk_fp8_f32(sp[4 * 33] * WG8_SCALE, sp[5 * 33] * WG8_SCALE, hi, false); hi = __builtin_amdgcn_cvt_pk_fp8_f32(sp[6 * 33] * WG8_SCALE, sp[7 * 33] * WG8_SCALE, hi, true);
        u32x2 o; o.x = lo; o.y = hi;
        *(u32x2*)(WT + (size_t)(n0 + n) * 4096 + k0 + 8 * c) = o; }
    LDS_WAIT(); asm volatile("" ::: "memory");
}
constexpr int PI1 = 32 * 144, PI2 = 32 * 256, PI3 = 16 * 64, PI4 = 8 * 64, PI5 = 8 * 64, PI6 = 32 * 64, PI7 = 32 * 176, PI8 = 32 * 176, PI9 = 88 * 64;
constexpr int PNIT = PI1 + PI2 + PI3 + PI4 + PI5 + PI6 + PI7 + PI8 + PI9, PIT_WA = PI1 + PI2, PIT_WE = PNIT - PI9;
__device__ __forceinline__ void prep_items(const Args& a, char* lds, int l, int it_lo, int it_hi, int wk, int nw) {
    const int tid = opaque_tid(), lane = tid & 63, wave = tid >> 6;
    float* scr = (float*)(lds + wave * 16384);
    bf16_t* WA = (bf16_t*)(a.ws + WS_WA); bf16_t* WB = (bf16_t*)(a.ws + WS_WB); bf16_t* WC = (bf16_t*)(a.ws + WS_WC);
    bf16_t* WD = (bf16_t*)(a.ws + WS_WD); bf16_t* WE = (bf16_t*)(a.ws + WS_WE);
    for (int it = it_lo + wk; it < it_hi; it += nw) {
        int r = it;
        if (r < PI1) { const int nb = r % 144, kb = r / 144; tr_item(a.in[I_WIN] + (size_t)l * DM * INW, INW, WA, DM, 0, 0, kb * 64, nb * 32, scr, lane); continue; } r -= PI1;
        if (r < PI2) { const int nb = r % 256, kb = r / 256; tr_item8(a.in[I_WGATE] + (size_t)l * DM * GW, GW, (unsigned char*)(a.ws + WS_WG8), kb * 64, nb * 32, scr, lane); continue; } r -= PI2;
        if (r < PI3) { const int nb = r % 64, kb = r / 64; tr_item(a.in[I_WBRA] + (size_t)l * 1024 * DM, DM, WB, BRK, 0, 0, kb * 64, nb * 32, scr, lane); continue; } r -= PI3;
        if (r < PI4) { const int nb = r % 64, kb = r / 64; tr_item(a.in[I_WBRS] + (size_t)l * 512 * DM, DM, WB, BRK, 0, 1536, kb * 64, nb * 32, scr, lane); continue; } r -= PI4;
        if (r < PI5) { const int nb = r % 64, kb = r / 64; tr_item(a.in[I_WBRC] + (size_t)l * 512 * DM, DM, WB, BRK, 0, 2048, kb * 64, nb * 32, scr, lane); continue; } r -= PI5;
        if (r < PI6) { const int nb = r % 64, kb = r / 64; tr_item(a.in[I_WO] + (size_t)l * DM * DM, DM, WC, DM, 0, 0, kb * 64, nb * 32, scr, lane); continue; } r -= PI6;
        if (r < PI7) { const int nb = r % 176, kb = r / 176; const int n0 = nb * 32; tr_item(a.in[I_WFG] + (size_t)l * DM * DFF, DFF, WD, DM, (n0 >> 7) * 256 + (n0 & 127) - n0, 0, kb * 64, n0, scr, lane); continue; } r -= PI7;
        if (r < PI8) { const int nb = r % 176, kb = r / 176; const int n0 = nb * 32; tr_item(a.in[I_WFU] + (size_t)l * DM * DFF, DFF, WD, DM, (n0 >> 7) * 256 + 128 + (n0 & 127) - n0, 0, kb * 64, n0, scr, lane); continue; } r -= PI8;
        { const int nb = r % 64, kb = r / 64; tr_item(a.in[I_WFD] + (size_t)l * DFF * DM, DM, WE, DFF, 0, 0, kb * 64, nb * 32, scr, lane); }
    }
}
__device__ __forceinline__ void prep_poolfold(const Args& a, int l, int wg, int nwg) {
    const int tid = opaque_tid();
    bf16_t* WB = (bf16_t*)(a.ws + WS_WB);
    const float* pw = a.in[I_POOLW] + (size_t)l * 4 * 128 * 128; const float* ps = a.in[I_POOLS] + (size_t)l * 512; const float* wbp = a.in[I_WBRP] + (size_t)l * 512 * DM;
    for (int it = wg; it < 128; it += nwg) {
        const int g = it >> 5, n = (it & 31) * 64 + (tid & 63), k16 = (tid >> 6) * 16;
        float acc[16];
#pragma unroll
        for (int q = 0; q < 16; ++q) acc[q] = 0.f;
        for (int j = 0; j < 128; ++j) { const float w = wbp[(size_t)(g * 128 + j) * DM + n] * ps[g * 128 + j];
#pragma unroll
            for (int q = 0; q < 16; ++q) acc[q] += pw[((size_t)g * 128 + k16 + q) * 128 + j] * w; }
        u32x4 o0, o1;
        o0.x = cvt_pk_bf16(acc[0], acc[1]); o0.y = cvt_pk_bf16(acc[2], acc[3]); o0.z = cvt_pk_bf16(acc[4], acc[5]); o0.w = cvt_pk_bf16(acc[6], acc[7]);
        o1.x = cvt_pk_bf16(acc[8], acc[9]); o1.y = cvt_pk_bf16(acc[10], acc[11]); o1.z = cvt_pk_bf16(acc[12], acc[13]); o1.w = cvt_pk_bf16(acc[14], acc[15]);
        bf16_t* dst = WB + (size_t)n * BRK + 1024 + g * 128 + k16;
        *(u32x4*)dst = o0; *(u32x4*)(dst + 8) = o1;
    }
}

__device__ __forceinline__ void phase_rows(const Args& a, int G, int mode, int nrows, const float* lng, const float* lnb, const float* modg, int goff,
                                           const float* xl_src, const float* xc_src, const float* modh, int sh_off, int sc_off, float* xl_out, bool w8) {
    unsigned char* H8 = a.ws + WS_H8;
    const int tid = opaque_tid(), lane = tid & 63, wave = tid >> 6;
    const int gw = blockIdx.x * 8 + wave, NGW = G * 8;
    const bf16_t* MB = (const bf16_t*)(a.ws + WS_P); float* xc_out = (float*)(a.ws + WS_XC); bf16_t* H = (bf16_t*)(a.ws + WS_H);
    f32x4 lg_[8], lb_[8];
    if (mode != 0) {
#pragma unroll
        for (int j = 0; j < 8; ++j) { const int c = 4 * (lane + 64 * j); lg_[j] = *(const f32x4*)(lng + c); lb_[j] = *(const f32x4*)(lnb + c); } }
    f32x4 v[8];
    if (gw < nrows) { const float* src = gw < ML ? xl_src + (size_t)gw * DM : xc_src + (size_t)(gw - ML) * DM;
#pragma unroll
        for (int j = 0; j < 8; ++j) v[j] = __builtin_nontemporal_load((const f32x4*)(src + 4 * (lane + 64 * j))); }
    for (int m = gw; m < nrows; m += NGW) {
        const int mrow = m < ML ? (m >> 11) : 8;
        f32x4 scv[8], shv[8];
        if (mode != 2) { const float* mr = modh + (size_t)mrow * MODW;
#pragma unroll
            for (int j = 0; j < 8; ++j) { const int c = 4 * (lane + 64 * j); scv[j] = *(const f32x4*)(mr + sc_off + c); shv[j] = *(const f32x4*)(mr + sh_off + c); } }
        if (mode != 0) {
            const bf16_t* mb = MB + (size_t)m * DM; const float* gr = modg + (size_t)mrow * MODW + goff;
            float s = 0.f;
#pragma unroll
            for (int j = 0; j < 8; ++j) { const int c = 4 * (lane + 64 * j); const u32x2 w = __builtin_nontemporal_load((const u32x2*)(mb + c)); const f32x4 g = *(const f32x4*)(gr + c);
                const f32x4 mv = {bflo(w.x), bfhi(w.x), bflo(w.y), bfhi(w.y)};
                v[j] = v[j] * ALPHA + g * mv; s += (v[j][0] + v[j][1]) + (v[j][2] + v[j][3]); }
            const float mean = wave_sum(s) * (1.f / DM); float s2 = 0.f;
#pragma unroll
            for (int j = 0; j < 8; ++j) { v[j] = v[j] - mean; s2 += (v[j][0] * v[j][0] + v[j][1] * v[j][1]) + (v[j][2] * v[j][2] + v[j][3] * v[j][3]); }
            const float rstd = 1.f / sqrtf(wave_sum(s2) * (1.f / DM) + LN_EPS);
#pragma unroll
            for (int j = 0; j < 8; ++j) v[j] = v[j] * rstd * lg_[j] + lb_[j];
        }
        const int mn = m + NGW; f32x4 vn[8];
        if (mn < nrows) { const float* srcn = mn < ML ? xl_src + (size_t)mn * DM : xc_src + (size_t)(mn - ML) * DM;
#pragma unroll
            for (int j = 0; j < 8; ++j) vn[j] = __builtin_nontemporal_load((const f32x4*)(srcn + 4 * (lane + 64 * j))); }
        if (mode != 0) { float* xo = m < ML ? xl_out + (size_t)m * DM : xc_out + (size_t)(m - ML) * DM;
#pragma unroll
            for (int j = 0; j < 8; ++j) __builtin_nontemporal_store(v[j], (f32x4*)(xo + 4 * (lane + 64 * j))); }
        if (mode != 2) {
#pragma unroll
            for (int j = 0; j < 8; ++j) { const int c = 4 * (lane + 64 * j);
                const f32x4 h = v[j] * (scv[j] + 1.f) + shv[j]; u32x2 w; w.x = cvt_pk_bf16(h[0], h[1]); w.y = cvt_pk_bf16(h[2], h[3]);
                *(u32x2*)(H + (size_t)m * DM + c) = w;
                if (w8) { unsigned q = 0; q = __builtin_amdgcn_cvt_pk_fp8_f32(h[0], h[1], q, false); q = __builtin_amdgcn_cvt_pk_fp8_f32(h[2], h[3], q, true); *(unsigned*)(H8 + (size_t)m * 4096 + c) = q; } }
        }
        if (mn < nrows) {
#pragma unroll
            for (int j = 0; j < 8; ++j) v[j] = vn[j]; }
    }
}

__device__ __forceinline__ void unpack8(const u32x4 w, float* f) { f[0] = bflo(w.x); f[1] = bfhi(w.x); f[2] = bflo(w.y); f[3] = bfhi(w.y); f[4] = bflo(w.z); f[5] = bfhi(w.z); f[6] = bflo(w.w); f[7] = bfhi(w.w); }
__device__ __forceinline__ u32x4 pack8(const float* f) { u32x4 w; w.x = cvt_pk_bf16(f[0], f[1]); w.y = cvt_pk_bf16(f[2], f[3]); w.z = cvt_pk_bf16(f[4], f[5]); w.w = cvt_pk_bf16(f[6], f[7]); return w; }

__device__ __forceinline__ void phase_local(const Args& a, char* lds, int G, int l) {
    const int tid = opaque_tid(), lane = tid & 63, wave = tid >> 6;
    const bf16_t* P = (const bf16_t*)(a.ws + WS_P); bf16_t* BR = (bf16_t*)(a.ws + WS_BR); bf16_t* QB = (bf16_t*)(a.ws + WS_QB);
    bf16_t* KB = (bf16_t*)(a.ws + WS_KB); bf16_t* VB = (bf16_t*)(a.ws + WS_VB);
    const float* rope = (const float*)(a.ws + WS_ROPE);
    const float* qg = a.in[I_QG] + l * 128; const float* kg = a.in[I_KG] + l * 128;
    const float* slng = a.in[I_SLNG] + l * 512; const float* slnb = a.in[I_SLNB] + l * 512;
    const float* sguw = a.in[I_SGUW] + (size_t)l * 4 * 128 * 128; const float* sgub = a.in[I_SGUB] + l * 512;
    const float* convw = a.in[I_CONVW] + l * 3 * 512;
    const bool last = (l == 1);
    const int nfull = last ? 128 : 144;
    const int nitems = nfull * 7 + (last ? 16 : 0);
    for (int it = blockIdx.x; it < nitems; it += G) {
        int ci, task;
        if (it < nfull * 7) { task = it / nfull; ci = it % nfull; } else { task = 0; ci = 128 + (it - nfull * 7); }
        int b, t0, n, m0;
        if (ci < 128) { b = ci >> 4; t0 = (ci & 15) * 128; n = SEQ; m0 = ci * 128; }
        else { const int cj = ci - 128; b = cj >> 1; t0 = (cj & 1) * 128; n = CTXL; m0 = ML + cj * 128; }
        const bool isctx = ci >= 128;
        if (task == 0) {
            const int hs = lane >> 4, i16 = lane & 15, e0 = i16 * 8;
            float gq[8], gk[8];
#pragma unroll
            for (int e = 0; e < 8; ++e) { gq[e] = qg[e0 + e]; gk[e] = kg[e0 + e]; }
            const bool lower = (i16 & 4) == 0;
            const int hg0 = (isctx && last) ? 2 : 0;
            for (int i = 0; i < 16; i += 2) {
                u32x4 raw[2][3], vraw[2]; f32x4 rp[2][4];
#pragma unroll
                for (int tk = 0; tk < 2; ++tk) { const size_t m = (size_t)m0 + wave * 16 + i + tk; const bf16_t* pr = P + m * INW;
#pragma unroll
                    for (int hg = 0; hg < 3; ++hg) if (hg >= hg0) raw[tk][hg] = *(const u32x4*)(pr + (hg * 4 + hs) * 128 + e0);
                    vraw[tk] = *(const u32x4*)(pr + 1280 + (lane & 31) * 8);
                    if (!isctx) { const int t = t0 + wave * 16 + i + tk; const int pos = i16 < 8 ? (t >> 6) : (t & 63); const float* rr = rope + (pos * 32 + 8 * (i16 & 3)) * 2;
#pragma unroll
                        for (int q = 0; q < 4; ++q) rp[tk][q] = *(const f32x4*)(rr + 4 * q); } }
#pragma unroll
                for (int tk = 0; tk < 2; ++tk) { const int tt = wave * 16 + i + tk, t = t0 + tt; const size_t m = (size_t)m0 + tt;
                    const int kvpos = isctx ? t : CTXL + t; const size_t kvrow = ((size_t)b * KVLEN + kvpos) * 256;
#pragma unroll
                    for (int hg = 0; hg < 3; ++hg) if (hg >= hg0) {
                        const int head = hg * 4 + hs;
                        float x[8]; unpack8(raw[tk][hg], x);
                        float ss = 0.f;
#pragma unroll
                        for (int e = 0; e < 8; ++e) ss += x[e] * x[e];
                        ss += __shfl_xor(ss, 1); ss += __shfl_xor(ss, 2); ss += __shfl_xor(ss, 4); ss += __shfl_xor(ss, 8);
                        const float r = 1.f / sqrtf(ss * (1.f / 128.f) + RMS_EPS);
                        float o[8];
#pragma unroll
                        for (int e = 0; e < 8; ++e) o[e] = x[e] * r * (hg < 2 ? gq[e] : gk[e]);
                        if (!isctx) {
#pragma unroll
                            for (int e = 0; e < 8; ++e) { const float pn = __shfl_xor(o[e], 4); const float cs = rp[tk][e >> 1][(e & 1) * 2], sn = rp[tk][e >> 1][(e & 1) * 2 + 1];
                                o[e] = lower ? o[e] * cs - pn * sn : o[e] * cs + pn * sn; } }
                        if (hg < 2) *(u32x4*)(QB + m * 1024 + head * 128 + e0) = pack8(o);
                        else if (hs < 2) *(u32x4*)(KB + kvrow + hs * 128 + e0) = pack8(o);
                    }
                    if (lane < 32) *(u32x4*)(VB + kvrow + lane * 8) = vraw[tk];
                }
            }
        } else if (task == 1) {
            const int g = wave >> 1, vec = lane & 15, sub = (lane >> 4) + 4 * (wave & 1), ch0 = g * 128 + vec * 8;
            const int w = 2 << g, left = w >> 1;
            const bf16_t* zb = P + ((size_t)m0 - t0) * INW + 1536 + ch0;
            for (int k = 0; k < 16; ++k) { const int tt = k * 8 + sub, t = t0 + tt;
                const u32x4 zc = *(const u32x4*)(zb + (size_t)t * INW);
                float s[8] = {0.f, 0.f, 0.f, 0.f, 0.f, 0.f, 0.f, 0.f}, z[8], f[8]; int cnt = 0;
#pragma unroll
                for (int hq = 0; hq < 16; hq += 8) if (hq < w) {
                    u32x4 rw[8];
#pragma unroll
                    for (int q = 0; q < 8; ++q) { int row = t - left + hq + q; row = row < 0 ? 0 : (row > n - 1 ? n - 1 : row); if (hq + q < w) rw[q] = *(const u32x4*)(zb + (size_t)row * INW); }
#pragma unroll
                    for (int q = 0; q < 8; ++q) if (hq + q < w) { const int row = t - left + hq + q; if (row >= 0 && row < n) { unpack8(rw[q], f); ++cnt;
#pragma unroll
                            for (int e = 0; e < 8; ++e) s[e] += f[e]; } } }
                unpack8(zc, z);
                const float inv = 1.f / (float)cnt;
#pragma unroll
                for (int e = 0; e < 8; ++e) f[e] = s[e] * inv - z[e];
                *(u32x4*)(BR + ((size_t)m0 + tt) * BRK + 1024 + ch0) = pack8(f); }
        } else if (task == 2) {
            float cw0[8], cw1[8], cw2[8]; const int vecc = tid & 63, chc = vecc * 8;
#pragma unroll
            for (int e = 0; e < 8; ++e) { cw0[e] = convw[chc + e]; cw1[e] = convw[512 + chc + e]; cw2[e] = convw[1024 + chc + e]; }
            for (int k = 0; k < 16; k += 2) {
                u32x4 ld[2][7];
#pragma unroll
                for (int u = 0; u < 2; ++u) { const int tt = (tid >> 6) + 8 * (k + u), t = t0 + tt; const bf16_t* pr = P + ((size_t)m0 + tt) * INW;
                    const bf16_t* pm = t > 0 ? pr - INW : pr; const bf16_t* pp = t < n - 1 ? pr + INW : pr;
                    ld[u][0] = *(const u32x4*)(pr + 3072 + chc); ld[u][1] = *(const u32x4*)(pr + 3584 + chc); ld[u][2] = *(const u32x4*)(pr + 4096 + chc);
                    ld[u][3] = *(const u32x4*)(pm + 3584 + chc); ld[u][4] = *(const u32x4*)(pm + 4096 + chc);
                    ld[u][5] = *(const u32x4*)(pp + 3584 + chc); ld[u][6] = *(const u32x4*)(pp + 4096 + chc); }
#pragma unroll
                for (int u = 0; u < 2; ++u) { const int tt = (tid >> 6) + 8 * (k + u), t = t0 + tt;
                    float cb[8], cc[8], cx[8], a1[8], a2[8], b1[8], b2[8], f[8];
                    unpack8(ld[u][0], cb); unpack8(ld[u][1], cc); unpack8(ld[u][2], cx); unpack8(ld[u][3], a1); unpack8(ld[u][4], a2); unpack8(ld[u][5], b1); unpack8(ld[u][6], b2);
                    const float mm = t > 0 ? 1.f : 0.f, mp = t < n - 1 ? 1.f : 0.f;
#pragma unroll
                    for (int e = 0; e < 8; ++e) f[e] = cb[e] * ((a1[e] * a2[e]) * (mm * cw0[e]) + (cc[e] * cx[e]) * cw1[e] + (b1[e] * b2[e]) * (mp * cw2[e]));
                    *(u32x4*)(BR + ((size_t)m0 + tt) * BRK + 2048 + chc) = pack8(f); }
            }
        } else {
            const int g = task - 3;
            bf16_t* Vt = (bf16_t*)lds;
            bf16_t* Ws = (bf16_t*)(lds + 128 * 272);
            u32x4 vr[16];
#pragma unroll
            for (int i = 0; i < 16; ++i) vr[i] = *(const u32x4*)(P + ((size_t)m0 + wave * 16 + i) * INW + 2560 + lane * 8);
            float lg[8], lb[8];
            { const int c0 = (lane & 15) * 8;
#pragma unroll
                for (int e = 0; e < 8; ++e) { lg[e] = slng[g * 128 + c0 + e]; lb[e] = slnb[g * 128 + c0 + e]; } }
#pragma unroll
            for (int i = 0; i < 16; ++i) { const int q = wave * 16 + i; float f[8];
                unpack8(vr[i], f);
                float s = 0.f;
#pragma unroll
                for (int e = 0; e < 8; ++e) { f[e] = gelu_tanh(f[e]); s += f[e]; }
                const float mean = wave_sum(s) * (1.f / 512.f); float s2 = 0.f;
#pragma unroll
                for (int e = 0; e < 8; ++e) { f[e] -= mean; s2 += f[e] * f[e]; }
                const float rstd = 1.f / sqrtf(wave_sum(s2) * (1.f / 512.f) + LN_EPS);
                if ((lane >> 4) == g) { const int c0 = (lane & 15) * 8;
#pragma unroll
                    for (int e = 0; e < 8; ++e) Vt[(c0 + e) * 136 + q] = f2bf(f[e] * rstd * lg[e] + lb[e]); } }
            { const int p = tid >> 2, q0 = (tid & 3) * 32; const float* wsrc = sguw + ((size_t)g * 128 + p) * 128 + q0;
#pragma unroll
                for (int k = 0; k < 4; ++k) { const f32x4 x0 = *(const f32x4*)(wsrc + 8 * k), x1 = *(const f32x4*)(wsrc + 8 * k + 4);
                    u32x4 w; w.x = cvt_pk_bf16(x0[0], x0[1]); w.y = cvt_pk_bf16(x0[2], x0[3]); w.z = cvt_pk_bf16(x1[0], x1[1]); w.w = cvt_pk_bf16(x1[2], x1[3]);
                    *(u32x4*)(Ws + p * 136 + q0 + 8 * k) = w; } }
            __syncthreads();
            f32x4 acc[8]; u32x2 uw[8];
            { const int p = 16 * wave + (lane & 15); const size_t m = (size_t)m0 + p;
#pragma unroll
                for (int i = 0; i < 8; ++i) uw[i] = *(const u32x2*)(P + m * INW + 2048 + g * 128 + 16 * i + 4 * (lane >> 4)); }
#pragma unroll
            for (int i = 0; i < 8; ++i) acc[i] = (f32x4){0.f, 0.f, 0.f, 0.f};
#pragma unroll
            for (int kk = 0; kk < 4; ++kk) { const bf16x8 bw = *(const bf16x8*)(Ws + (16 * wave + (lane & 15)) * 136 + kk * 32 + (lane >> 4) * 8);
#pragma unroll
                for (int i = 0; i < 8; ++i) { const bf16x8 av = *(const bf16x8*)(Vt + (16 * i + (lane & 15)) * 136 + kk * 32 + (lane >> 4) * 8);
                    acc[i] = __builtin_amdgcn_mfma_f32_16x16x32_bf16(av, bw, acc[i], 0, 0, 0); } }
            { const int p = 16 * wave + (lane & 15); const size_t m = (size_t)m0 + p; const float bias = sgub[g * 128 + p];
#pragma unroll
                for (int i = 0; i < 8; ++i) { const int c = 16 * i + 4 * (lane >> 4);
                    const float y0 = gelu_tanh(bflo(uw[i].x)) * (acc[i][0] + bias), y1 = gelu_tanh(bfhi(uw[i].x)) * (acc[i][1] + bias);
                    const float y2 = gelu_tanh(bflo(uw[i].y)) * (acc[i][2] + bias), y3 = gelu_tanh(bfhi(uw[i].y)) * (acc[i][3] + bias);
                    u32x2 w; w.x = cvt_pk_bf16(y0, y1); w.y = cvt_pk_bf16(y2, y3);
                    *(u32x2*)(BR + m * BRK + 1536 + g * 128 + c) = w; } }
            __syncthreads();
        }
    }
}

__device__ __forceinline__ void phase_attn(const Args& a, char* lds, int G, int l) {
    const bf16_t* QB = (const bf16_t*)(a.ws + WS_QB); const bf16_t* KB = (const bf16_t*)(a.ws + WS_KB); const bf16_t* VB = (const bf16_t*)(a.ws + WS_VB);
    bf16_t* BR = (bf16_t*)(a.ws + WS_BR);
    const int c = blockIdx.x;
    for (int i = 0; i * G + c < 512; ++i) {
        int b, h, qb;
        if (G == 256) { const int grp = (c & 7) + 8 * i, j = c >> 3; b = grp >> 1; h = (grp & 1) * 4 + (j >> 3); qb = j & 7; }
        else { const int u = i * G + c; b = u >> 6; h = (u >> 3) & 7; qb = u & 7; }
        const size_t qrow = (size_t)b * SEQ + qb * 256;
        att::attn_dense_body(QB + qrow * 1024 + h * 128, KB + (size_t)b * KVLEN * 256 + (h >> 2) * 128, VB + (size_t)b * KVLEN * 256 + (h >> 2) * 128,
                             BR + qrow * BRK + h * 128, KVLEN, lds);
    }
    if (l == 0) for (int u = c; u < 64; u += G) {
        const int b = u >> 3, h = u & 7; const size_t qrow = (size_t)ML + b * CTXL;
        att::attn_dense_body(QB + qrow * 1024 + h * 128, KB + (size_t)b * KVLEN * 256 + (h >> 2) * 128, VB + (size_t)b * KVLEN * 256 + (h >> 2) * 128,
                             BR + qrow * BRK + h * 128, CTXL, lds);
    }
}

constexpr int NPHASE = 20;
__global__ void __launch_bounds__(512, 2) mega_fwd(Args a) {
    extern __shared__ __attribute__((aligned(16))) unsigned char lds[];
    const int G = gridDim.x, c = blockIdx.x;
    LAS unsigned char* ldsl = (LAS unsigned char*)lds;
    float* modb = (float*)(a.ws + WS_MOD);
    volatile LAS unsigned* bst = (volatile LAS unsigned*)(ldsl + 131072 + 512);
    if (threadIdx.x < 2) bst[threadIdx.x] = 0u;
    __syncthreads();
    XcdBarrier bar = xcd_barrier_post((unsigned*)(a.ws + WS_BAR), bst);
    if (a.ph_hi < 0) cg::this_grid().sync();
#define GRID_SYNC() xcd_barrier(bar)
    int rep = 0; (void)rep;
    for (int ph = a.ph_lo; ph < a.ph_hi; ++ph) {
        if (ph == 0) { phase_mods(a, (char*)lds, 0, 1, c, G, c == G - 1); __syncthreads();     prep_items(a, (char*)lds, 0, 0, PIT_WA, c * 8 + (opaque_tid() >> 6), G * 8); }
        else if (ph == 1) { phase_rows(a, G, 0, MT, nullptr, nullptr, nullptr, 0, a.in[I_X], a.in[I_CTX], modb, 0, DM, nullptr, true); }
        else {
            const int l = (ph - 2) / 9, k = (ph - 2) % 9; const bool last = (l == 1);
            const float* mod = modb + (size_t)l * 9 * MODW;
            const int nM = last ? 64 : 72;
            if (k == 0) {
                {
                    pg8::SchedG S{(const char*)(a.ws + WS_H), (const char*)(a.ws + WS_WA), DM * 2, nM, 18, 32, G, c, last ? 16 : 0, 64, 4, 8, 0};
                    pg8::EpiP E{(bf16_t*)(a.ws + WS_P)};
                    pg8::gemm_phase(ldsl, DM, S, E); }
                {
                    pg8::SchedG S{(const char*)(a.ws + WS_H8), (const char*)(a.ws + WS_WG8), 4096, nM, 32, 16, G, c, 0, 0, 0, 1, 18};
                    pg8::EpiG E{(bf16_t*)(a.ws + WS_G), a.in[I_BGATE] + (size_t)l * GW};
                    pg8::gemm_phase<pg8::EpiG, pg8::SchedG, true>(ldsl, DM, S, E); }
                if (!last) { const int busy = (nM * 18) % G;
                    if (c >= busy) { prep_items(a, (char*)lds, 0, PIT_WA, PNIT, (c - busy) * 8 + (opaque_tid() >> 6), (G - busy) * 8); prep_poolfold(a, 0, c - busy, G - busy); } }
            } else if (k == 1) phase_local(a, (char*)lds, G, l);
            else if (k == 2) phase_attn(a, (char*)lds, G, l);
            else if (k == 3) {
                pg8::SchedSeg S{(const char*)(a.ws + WS_BR), (const char*)(a.ws + WS_WB), BRK, nM, 8, G, c};
                pg8::EpiB E{(bf16_t*)(a.ws + WS_H), (const bf16_t*)(a.ws + WS_G)};
                pg8::gemm_phase(ldsl, BRK, S, E);
                if (!last) { const int busy = (nM * 8) % G;
                    if (c >= busy) phase_mods(a, (char*)lds, 1, 2, c - busy, G - busy, false); }
            } else if (k == 4 || k == 7) {
                const bool mix = (k == 4);
                const int ld = mix ? DM : DFF;
                pg8::SchedG S{(const char*)(a.ws + (mix ? WS_H : WS_G)), (const char*)(a.ws + (mix ? WS_WC : WS_WE)), ld * 2, nM, 8, ld / 64, G, c, 0, 0, 0, 1, 0};
                pg8::EpiRaw E{(bf16_t*)(a.ws + WS_P), DM};
                pg8::gemm_phase(ldsl, ld, S, E);
                if (!last) { const int busy = (nM * 8) % G;
                    if (c >= busy) { const int wk = (c - busy) * 8 + (opaque_tid() >> 6), nw = (G - busy) * 8;
                        if (mix) prep_items(a, (char*)lds, 1, 0, PIT_WA, wk, nw);
                        else { prep_items(a, (char*)lds, 1, PIT_WA, PIT_WE, wk, nw); prep_poolfold(a, 1, c - busy, G - busy); } } }
            } else if (k == 5) phase_rows(a, G, 1, nM * 256, a.in[I_LN1G] + l * DM, a.in[I_LN1B] + l * DM, mod, 2 * DM,
                                          l == 0 ? a.in[I_X] : a.out, l == 0 ? a.in[I_CTX] : (const float*)(a.ws + WS_XC), mod, 3 * DM, 4 * DM, a.out, false);
            else if (k == 6) {
                pg8::SchedG S{(const char*)(a.ws + WS_H), (const char*)(a.ws + WS_WD), DM * 2, nM, 44, 32, G, c, 0, 0, 0, 1, 0};
                pg8::EpiSwiglu E{(bf16_t*)(a.ws + WS_G)};
                pg8::gemm_phase(ldsl, DM, S, E);
            } else {
                if (!last) { phase_rows(a, G, 1, MT, a.in[I_LN2G], a.in[I_LN2B], mod, 5 * DM, a.out, (const float*)(a.ws + WS_XC), modb + (size_t)9 * MODW, 0, DM, a.out, true); prep_items(a, (char*)lds, 1, PIT_WE, PNIT, c * 8 + (opaque_tid() >> 6), G * 8); }
                else phase_rows(a, G, 2, ML, a.in[I_LN2G] + DM, a.in[I_LN2B] + DM, mod, 5 * DM, a.out, nullptr, nullptr, 0, 0, a.out, false);
            }
        }
#ifdef PROBE_DUP
        {
            const int kk = ph < 2 ? -1 : (ph - 2) % 9;
            const bool isgemm = kk == 0 || kk == 3 || kk == 4 || kk == 6 || kk == 7, isattn = kk == 2;
            const bool dup = (PROBE_DUP == 1 && isgemm) || (PROBE_DUP == 3 && !isgemm && !isattn) || (PROBE_DUP == 4 && isattn) || (PROBE_DUP == 5 && kk == 1) || (PROBE_DUP == 6 && ph < 2) || (PROBE_DUP == 7 && kk == 0) || (PROBE_DUP == 8 && kk == 3) || (PROBE_DUP == 9 && kk == 6);
            if (PROBE_DUP == 2) GRID_SYNC();
            if (dup && rep == 0) { GRID_SYNC(); rep = 1; --ph; continue; }
            rep = 0;
        }
#endif
        if (ph + 1 < a.ph_hi) GRID_SYNC();
    }
#ifdef DBG_PH
    GRID_SYNC();
    {
        const int gt = blockIdx.x * 512 + threadIdx.x, NT = gridDim.x * 512;
        for (size_t i = gt; i < (size_t)ML * DM; i += NT) { const size_t m = i >> 11; const int cc = (int)(i & 2047);
#if DBG_KIND == 0
            a.out[i] = ((const float*)(a.ws + DBG_SRC))[m * DBG_LD + DBG_COL0 + cc];
#else
            a.out[i] = bf2f(((const bf16_t*)(a.ws + DBG_SRC))[m * DBG_LD + DBG_COL0 + cc]);
#endif
        }
    }
#endif
}

extern "C" void kernel_launch(void* const* d_in, const int* in_sizes, int n_in, void* d_out, int out_size, void* d_ws, size_t ws_size, hipStream_t stream) {
    static int grid = 0;
    if (grid == 0) {
        if (n_in != 30 || in_sizes[0] != ML * DM || out_size != ML * DM || ws_size < WS_END) {
            fprintf(stderr, "kernel_launch: unexpected shapes: n_in %d in0 %d out %d ws %zu (need %zu)\n", n_in, n_in > 0 ? in_sizes[0] : -1, out_size, ws_size, (size_t)WS_END); grid = -1; return; }
        int dev = 0, cus = 0, per_cu = 0;
        hipGetDevice(&dev); hipDeviceGetAttribute(&cus, hipDeviceAttributeMultiprocessorCount, dev);
        if (hipFuncSetAttribute((const void*)mega_fwd, hipFuncAttributeMaxDynamicSharedMemorySize, LDS_BYTES) != hipSuccess) { fprintf(stderr, "kernel_launch: hipFuncSetAttribute failed\n"); grid = -1; return; }
        if (hipOccupancyMaxActiveBlocksPerMultiprocessor(&per_cu, (const void*)mega_fwd, 512, LDS_BYTES) != hipSuccess || per_cu < 1) { fprintf(stderr, "kernel_launch: occupancy query gave %d\n", per_cu); per_cu = 1; }
        (void)hipGetLastError();
        grid = cus * per_cu;
        fprintf(stderr, "kernel_launch: grid %d (cus %d x %d)\n", grid, cus, per_cu);
    }
    if (grid < 0) return;
    Args a{};
    for (int i = 0; i < 30; ++i) a.in[i] = (const float*)d_in[i];
    a.out = (float*)d_out; a.ws = (unsigned char*)d_ws;
#if MK_ONE_LAUNCH
    (void)hipMemsetAsync((char*)d_ws + WS_BAR, 0, 16384, stream);
#ifdef DBG_PH
    a.ph_lo = 0; a.ph_hi = DBG_PH + 1;
#else
    a.ph_lo = 0; a.ph_hi = NPHASE;
#endif
    void* kargs[] = {&a};
    hipError_t e = hipLaunchCooperativeKernel((const void*)mega_fwd, dim3(grid), dim3(512), kargs, LDS_BYTES, stream);
    if (e != hipSuccess) fprintf(stderr, "cooperative launch failed: %s (grid %d)\n", hipGetErrorString(e), grid);
#else
    for (int ph = 0; ph < NPHASE; ++ph) {
        a.ph_lo = ph; a.ph_hi = ph + 1;
        hipLaunchKernelGGL(mega_fwd, dim3(grid), dim3(512), LDS_BYTES, stream, a);
    }
#endif
}
```
